# Optimizing an MI355X kernel written in HIP

```python
import math
import jax, jax.numpy as jnp
from jax import lax
import numpy as np

D_MODEL = 1024
BATCH = 8
SEQ = 2048
DEPTH = 4

HEAD_DIM = 64
DIFF_HEADS = 4
DIFF_VDIM = 2 * HEAD_DIM
SB_HEADS = 8
DIFF_WIDTH = DIFF_HEADS * DIFF_VDIM
SB_WIDTH = SB_HEADS * HEAD_DIM
MIX_WIDTH = DIFF_WIDTH + SB_WIDTH
DIFF_QK = DIFF_HEADS * 2 * HEAD_DIM
SB_QK = SB_HEADS * HEAD_DIM
IN_WIDTH = 2 * DIFF_QK + DIFF_WIDTH + 2 * SB_QK + SB_WIDTH
Q_BLOCK = 128

PEER_HEADS = 8
N_KEYS = 128
N_EXPERTS = N_KEYS * N_KEYS
PEER_TOPK = 16
HALF_Q = 128
QUERY_DIM = 2 * HALF_Q
TOKEN_CHUNK = 128

DEEPNORM_ALPHA = (2.0 * DEPTH) ** 0.25
DEEPNORM_BETA = (8.0 * DEPTH) ** -0.25
LN_EPS = 1e-5
RMS_EPS = 1e-5

kernel_name = "hymba_diff_stickbreak_peer_deepnorm"


def layer_norm(h, g, b):
    hf = h.astype(jnp.float32)
    mu = jnp.mean(hf, axis=-1, keepdims=True)
    var = jnp.mean(jnp.square(hf - mu), axis=-1, keepdims=True)
    y = (hf - mu) * lax.rsqrt(var + LN_EPS) * g.astype(jnp.float32) + b.astype(jnp.float32)
    return y.astype(h.dtype)


def alibi_slopes():
    return jnp.asarray([2.0 ** (-8.0 * (i + 1) / DIFF_HEADS) for i in range(DIFF_HEADS)], jnp.float32)


def token_mixer(h, w_in, lq1, lk1, lq2, lk2, subln_g, w_o, layer):
    B, S, _ = h.shape
    proj = h @ w_in
    s1 = DIFF_QK
    s2 = s1 + DIFF_QK
    s3 = s2 + DIFF_WIDTH
    s4 = s3 + SB_QK
    s5 = s4 + SB_QK
    dq, dk, dv, sq, sk, sv = jnp.split(proj, [s1, s2, s3, s4, s5], axis=-1)
    dq = dq.reshape(B, S, DIFF_HEADS, 2, HEAD_DIM).transpose(0, 2, 3, 1, 4)
    dk = dk.reshape(B, S, DIFF_HEADS, 2, HEAD_DIM).transpose(0, 2, 3, 1, 4)
    dv = dv.reshape(B, S, DIFF_HEADS, DIFF_VDIM).transpose(0, 2, 1, 3)
    sq = sq.reshape(B, S, SB_HEADS, HEAD_DIM).transpose(0, 2, 1, 3)
    sk = sk.reshape(B, S, SB_HEADS, HEAD_DIM).transpose(0, 2, 1, 3)
    sv = sv.reshape(B, S, SB_HEADS, HEAD_DIM).transpose(0, 2, 1, 3)

    lambda_init = 0.8 - 0.6 * math.exp(-0.3 * layer)
    lam = (jnp.exp(jnp.sum(lq1.astype(jnp.float32) * lk1.astype(jnp.float32)))
           - jnp.exp(jnp.sum(lq2.astype(jnp.float32) * lk2.astype(jnp.float32)))
           + lambda_init)
    slopes = alibi_slopes()[None, :, None, None, None]
    scale = HEAD_DIM ** -0.5

    diff_out, sb_out = [], []
    for blk in range(S // Q_BLOCK):
        q0 = blk * Q_BLOCK
        kv_len = q0 + Q_BLOCK
        t_pos = q0 + jnp.arange(Q_BLOCK)
        s_pos = jnp.arange(kv_len)
        dist = (t_pos[:, None] - s_pos[None, :]).astype(jnp.float32)

        sc = jnp.einsum('bhmqd,bhmkd->bhmqk', dq[:, :, :, q0:kv_len], dk[:, :, :, :kv_len]).astype(jnp.float32) * scale
        sc = jnp.where(dist >= 0, sc - slopes * dist, -jnp.inf)
        p = jax.nn.softmax(sc, axis=-1)
        attn = p[:, :, 0] - lam * p[:, :, 1]
        diff_out.append(jnp.einsum('bhqk,bhkd->bhqd', attn.astype(dv.dtype), dv[:, :, :kv_len]))

        z = jnp.einsum('bgqd,bgkd->bgqk', sq[:, :, q0:kv_len], sk[:, :, :kv_len]).astype(jnp.float32) * scale
        strict = dist > 0
        log_fail = jnp.where(strict, jax.nn.log_sigmoid(-z), 0.0)
        log_later = lax.cumsum(log_fail, axis=3, reverse=True) - log_fail
        w = jnp.where(strict, jnp.exp(jax.nn.log_sigmoid(z) + log_later), 0.0)
        sb_out.append(jnp.einsum('bgqk,bgkd->bgqd', w.astype(sv.dtype), sv[:, :, :kv_len]))

    diff = jnp.concatenate(diff_out, axis=2).astype(jnp.float32)
    diff = diff * lax.rsqrt(jnp.mean(jnp.square(diff), axis=-1, keepdims=True) + RMS_EPS)
    diff = diff * subln_g.astype(jnp.float32) * (1.0 - lambda_init)
    diff = diff.astype(h.dtype).transpose(0, 2, 1, 3).reshape(B, S, DIFF_WIDTH)
    sb = jnp.concatenate(sb_out, axis=2).transpose(0, 2, 1, 3).reshape(B, S, SB_WIDTH)
    mixed = jnp.concatenate([diff, sb.astype(h.dtype)], axis=-1)
    return mixed @ w_o


def peer_ffn(h, w_query, sub_keys, expert_u, expert_v):
    B, S, D = h.shape
    T = B * S
    xt = h.reshape(T, D)
    q = (xt @ w_query).reshape(T, PEER_HEADS, 2, HALF_Q).astype(jnp.float32)
    scores = jnp.einsum('thpc,hpnc->thpn', q, sub_keys.astype(jnp.float32))
    top_s, top_i = lax.top_k(scores, PEER_TOPK)
    cand_s = top_s[:, :, 0, :, None] + top_s[:, :, 1, None, :]
    cand_i = top_i[:, :, 0, :, None] * N_KEYS + top_i[:, :, 1, None, :]
    cand_s = cand_s.reshape(T, PEER_HEADS, PEER_TOPK * PEER_TOPK)
    cand_i = cand_i.reshape(T, PEER_HEADS, PEER_TOPK * PEER_TOPK)
    best_s, best_pos = lax.top_k(cand_s, PEER_TOPK)
    idx = jnp.take_along_axis(cand_i, best_pos, axis=-1)
    gate = jax.nn.softmax(best_s, axis=-1)
    n_sel = PEER_HEADS * PEER_TOPK
    n_chunks = T // TOKEN_CHUNK

    def expert_chunk(args):
        xc, ic, gc = args
        u = expert_u[ic]
        act = jax.nn.gelu(jnp.einsum('cd,ced->ce', xc, u).astype(jnp.float32), approximate=False)
        v = expert_v[ic]
        return jnp.einsum('ce,ced->cd', (gc * act).astype(v.dtype), v)

    y = lax.map(expert_chunk, (xt.reshape(n_chunks, TOKEN_CHUNK, D),
                               idx.reshape(n_chunks, TOKEN_CHUNK, n_sel),
                               gate.reshape(n_chunks, TOKEN_CHUNK, n_sel)))
    return y.reshape(B, S, D).astype(h.dtype)


def setup_inputs(seed: int = 0) -> dict:
    key = jax.random.key(seed)
    ks = jax.random.split(key, 16)
    f32 = jnp.float32
    beta = DEEPNORM_BETA
    col_scale = np.concatenate([np.ones(2 * DIFF_QK), np.full(DIFF_WIDTH, beta),
                                np.ones(2 * SB_QK), np.full(SB_WIDTH, beta)]).astype(np.float32)
    x = jax.random.normal(ks[0], (BATCH, SEQ, D_MODEL), f32)
    w_in = jax.random.normal(ks[1], (DEPTH, D_MODEL, IN_WIDTH), f32) * (D_MODEL ** -0.5) * jnp.asarray(col_scale)
    lam_q1 = 0.1 * jax.random.normal(ks[2], (DEPTH, HEAD_DIM), f32)
    lam_k1 = 0.1 * jax.random.normal(ks[3], (DEPTH, HEAD_DIM), f32)
    lam_q2 = 0.1 * jax.random.normal(ks[4], (DEPTH, HEAD_DIM), f32)
    lam_k2 = 0.1 * jax.random.normal(ks[5], (DEPTH, HEAD_DIM), f32)
    subln_g = 1.0 + 0.02 * jax.random.normal(ks[6], (DEPTH, DIFF_VDIM), f32)
    w_o = jax.random.normal(ks[7], (DEPTH, MIX_WIDTH, D_MODEL), f32) * (MIX_WIDTH ** -0.5) * beta
    ln1_g = 1.0 + 0.02 * jax.random.normal(ks[8], (DEPTH, D_MODEL), f32)
    ln1_b = 0.02 * jax.random.normal(ks[9], (DEPTH, D_MODEL), f32)
    w_query = jax.random.normal(ks[10], (DEPTH, D_MODEL, PEER_HEADS * QUERY_DIM), f32) * (D_MODEL ** -0.5)
    sub_keys = jax.random.normal(ks[11], (DEPTH, PEER_HEADS, 2, N_KEYS, HALF_Q), f32) * (HALF_Q ** -0.5)
    expert_u = jax.random.normal(ks[12], (DEPTH, N_EXPERTS, D_MODEL), f32) * (D_MODEL ** -0.5) * beta
    expert_v = jax.random.normal(ks[13], (DEPTH, N_EXPERTS, D_MODEL), f32) * beta
    ln2_g = 1.0 + 0.02 * jax.random.normal(ks[14], (DEPTH, D_MODEL), f32)
    ln2_b = 0.02 * jax.random.normal(ks[15], (DEPTH, D_MODEL), f32)
    return {"x": x, "w_in": w_in, "lam_q1": lam_q1, "lam_k1": lam_k1, "lam_q2": lam_q2,
            "lam_k2": lam_k2, "subln_g": subln_g, "w_o": w_o, "ln1_g": ln1_g, "ln1_b": ln1_b,
            "w_query": w_query, "sub_keys": sub_keys, "expert_u": expert_u, "expert_v": expert_v,
            "ln2_g": ln2_g, "ln2_b": ln2_b}


def reference(x, w_in, lam_q1, lam_k1, lam_q2, lam_k2, subln_g, w_o, ln1_g, ln1_b,
              w_query, sub_keys, expert_u, expert_v, ln2_g, ln2_b):
    h = x
    for l in range(DEPTH):
        mix = token_mixer(h, w_in[l], lam_q1[l], lam_k1[l], lam_q2[l], lam_k2[l], subln_g[l], w_o[l], l)
        h = layer_norm(DEEPNORM_ALPHA * h + mix, ln1_g[l], ln1_b[l])
        ffn = peer_ffn(h, w_query[l], sub_keys[l], expert_u[l], expert_v[l])
        h = layer_norm(DEEPNORM_ALPHA * h + ffn, ln2_g[l], ln2_b[l])
    return h
```

```cpp
#include <hip/hip_runtime.h>
#include <hip/hip_cooperative_groups.h>
#include <cstdio>
#include <cstdint>
#ifndef MK_SINGLE
#define MK_SINGLE 0
#endif
__device__ __forceinline__ int opaque_tid() { int t = threadIdx.x; asm volatile("" : "+v"(t)); return t; }
namespace pg8 {
#define PG8_LAS __attribute__((address_space(3)))
typedef unsigned short bf16_t;
typedef short bf16x8 __attribute__((ext_vector_type(8)));
typedef float f32x4 __attribute__((ext_vector_type(4)));
typedef unsigned u32x4 __attribute__((ext_vector_type(4)));
constexpr int BM = 256, BK = 64, HALF = 128, HTB = HALF * BK * 2  , STAGE_BYTES = 8 * HTB, NXCD = 8, WGM = 8;

__host__ __device__ __forceinline__ int lds_byte(int r, int c) { const int st = (r >> 4) * 2 + (c >> 5), rr = r & 15, cc = c & 31, ob = rr * 64 + cc * 2; return st * 1024 + (ob ^ (((ob >> 9) & 1) << 5)); }
__host__ __device__ __forceinline__ void stage_rc(int b, int& R, int& C) { const int st = b / 1024, sb = b % 1024, swz = sb ^ (((sb >> 9) & 1) << 5); R = (st >> 1) * 16 + swz / 64; C = (st & 1) * 32 + (swz % 64) / 2; }
__host__ __device__ __forceinline__ int perm32(int rho) { const int n = rho >> 4, i = rho & 15; return 8 * (i >> 2) + 4 * n + (i & 3); }

struct Unit { int pm, pn; };
struct Gemm { const bf16_t* A; const bf16_t* Bt; int M, N, K; };

struct StaticOrder {
    int nM, nN, nwg, G, c;
    __host__ __device__ void init(int M, int N, int G_, int c_) { nM = M / BM; nN = N / BM; nwg = nM * nN; G = G_; c = c_; }
    __host__ __device__ bool next(int i, Unit& u) const {
        const long L = (long)i * G + c; if (L >= nwg) return false;
        int wgid = (int)L; { const int q = nwg / NXCD, r = nwg % NXCD, xcd = wgid % NXCD, off = wgid / NXCD; wgid = (xcd < r ? xcd * (q + 1) : r * (q + 1) + (xcd - r) * q) + off; }
        const int nig = WGM * nN, gid = wgid / nig, fm = gid * WGM, gsz = (nM - fm) < WGM ? (nM - fm) : WGM;
        u.pm = fm + ((wgid % nig) % gsz); u.pn = (wgid % nig) / gsz; return true;
    }
    __device__ __forceinline__ void a_ready(const Unit&) const {}
    __device__ __forceinline__ void done(const Unit&) const {}
};

__device__ __forceinline__ unsigned cvt_pk_bf16(float lo, float hi) { unsigned r; asm volatile("v_cvt_pk_bf16_f32 %0, %1, %2" : "=v"(r) : "v"(lo), "v"(hi)); return r; }
typedef float f32x2 __attribute__((ext_vector_type(2)));
__device__ __forceinline__ f32x2 gelu_pk(f32x2 v) {
    const f32x2 av = __builtin_elementwise_abs(v), d = av * 0.2316418882f + 1.0f;
    f32x2 t; t.x = __builtin_amdgcn_rcpf(d.x); t.y = __builtin_amdgcn_rcpf(d.y);
    f32x2 q = t * 0.5307027145f + (-0.7265760135f); q = q * t + 0.7107068705f; q = q * t + (-0.142248368f); q = q * t + 0.127414796f; q = q * t;
    const f32x2 s = (v * v) * (-0.72134752044f);
    f32x2 e; e.x = __builtin_amdgcn_exp2f(s.x); e.y = __builtin_amdgcn_exp2f(s.y);
    const f32x2 m = v * (q * e), r = v - m;
    f32x2 o; o.x = v.x < 0.f ? m.x : r.x; o.y = v.y < 0.f ? m.y : r.y; return o;
}

template <int ACT  > struct EpiBf16 {
    static constexpr bool PERM = true, AFTER_DRAIN = false; static_assert(ACT == 0 || ACT == 1, "EpiBf16: ACT is 0 (none) or 1 (gelu_pk)");
    bf16_t* O; int ldc; const float* bias; int split_cols; size_t split_stride; float scale0;
    __device__ __forceinline__ void operator()(const f32x4 (&acc)[2][2][4][2], const Unit& u, int wr, int wc, int fr, int fq) const {
        const int row0 = u.pm * BM + wr * 64 + fr; int colt = u.pn * BM; bf16_t* base = O;
        float sc = 1.f; if (split_cols) { const int t = colt / split_cols; base += (size_t)t * split_stride; colt -= t * split_cols; if (t == 0) sc = scale0; }
        const int col0 = colt + wc * 32 + 8 * fq, bcol0 = u.pn * BM + wc * 32 + 8 * fq;
        f32x4 bv[2][2];
#pragma unroll
        for (int bj = 0; bj < 2; ++bj)
#pragma unroll
            for (int n = 0; n < 2; ++n) bv[bj][n] = bias ? *(const f32x4*)(bias + bcol0 + bj * HALF + 4 * n) : (f32x4){0.f, 0.f, 0.f, 0.f};
#pragma unroll
        for (int ai = 0; ai < 2; ++ai)
#pragma unroll
            for (int m = 0; m < 4; ++m) { bf16_t* rowp = base + (size_t)(row0 + ai * HALF + m * 16) * ldc + col0;
#pragma unroll
                for (int bj = 0; bj < 2; ++bj) { f32x4 v0 = acc[ai][bj][m][0] + bv[bj][0], v1 = acc[ai][bj][m][1] + bv[bj][1];
                    if (ACT == 1) { f32x2 a = gelu_pk((f32x2){v0[0], v0[1]}), b = gelu_pk((f32x2){v0[2], v0[3]}), c = gelu_pk((f32x2){v1[0], v1[1]}), d = gelu_pk((f32x2){v1[2], v1[3]});
                        v0 = (f32x4){a.x, a.y, b.x, b.y}; v1 = (f32x4){c.x, c.y, d.x, d.y}; }
                    v0 = v0 * sc; v1 = v1 * sc; u32x4 w; w.x = cvt_pk_bf16(v0[0], v0[1]); w.y = cvt_pk_bf16(v0[2], v0[3]); w.z = cvt_pk_bf16(v1[0], v1[1]); w.w = cvt_pk_bf16(v1[2], v1[3]);
                    *(u32x4*)(rowp + bj * HALF) = w; } }
    }
};

struct PanelStats {
    unsigned* xbuf;
    unsigned* cnt;
    unsigned* tmo;
    int ntn; float eps;
    unsigned code;
    __device__ __forceinline__ bool run(const f32x4 (&v)[2][2][4][2], const Unit& u, int wr, int wc, int fr, int fq, PG8_LAS unsigned char* lds, int wid, int lane) const {
        typedef float f32x2v __attribute__((ext_vector_type(2)));
        PG8_LAS f32x2v* P = (PG8_LAS f32x2v*)lds;
        PG8_LAS f32x2v* S = (PG8_LAS f32x2v*)(lds + 8192);
        PG8_LAS unsigned* flag = (PG8_LAS unsigned*)(lds + 8192 + 2048);
#pragma unroll
        for (int ai = 0; ai < 2; ++ai)
#pragma unroll
            for (int m = 0; m < 4; ++m) {
                float s = 0.f;
#pragma unroll
                for (int bj = 0; bj < 2; ++bj)
#pragma unroll
                    for (int n = 0; n < 2; ++n) { const f32x4 x = v[ai][bj][m][n]; s += (x[0] + x[1]) + (x[2] + x[3]); }
                s += __shfl_xor(s, 16); s += __shfl_xor(s, 32);
                const float mw = s * (1.0f / 64.0f); float q = 0.f;
#pragma unroll
                for (int bj = 0; bj < 2; ++bj)
#pragma unroll
                    for (int n = 0; n < 2; ++n) { const f32x4 d = v[ai][bj][m][n] - mw; q += (d[0] * d[0] + d[1] * d[1]) + (d[2] * d[2] + d[3] * d[3]); }
                q += __shfl_xor(q, 16); q += __shfl_xor(q, 32);
                if (fq == 0) P[(ai * HALF + wr * 64 + m * 16 + fr) * 4 + wc] = (f32x2v){mw, q};
            }
        asm volatile("s_waitcnt lgkmcnt(0)" ::: "memory"); __builtin_amdgcn_s_barrier(); asm volatile("" ::: "memory");
#if defined(BROKEN_EXCHANGE_NO_WAIT)
#warning BROKEN CONTROL BUILD: the row-statistics exchange does not wait; results are wrong by design
        if (blockIdx.x >= 64) { const long long t0_ = clock64(); while (clock64() - t0_ < 60000) __builtin_amdgcn_s_sleep(8); }
#endif
        const int row = wid * 32 + (lane & 31);
        if (lane < 32) {
            const f32x2v a = P[row * 4 + 0], b = P[row * 4 + 1], c = P[row * 4 + 2], d = P[row * 4 + 3];
            const float mt = (a.x + b.x + c.x + d.x) * 0.25f;
            const float da = a.x - mt, db = b.x - mt, dc = c.x - mt, dd = d.x - mt;
            const float m2 = (a.y + b.y) + (c.y + d.y) + 64.0f * ((da * da + db * db) + (dc * dc + dd * dd));
            unsigned long long* slot = (unsigned long long*)xbuf + ((size_t)(u.pm * BM + row) * 4 + u.pn);
            __hip_atomic_store(slot, ((unsigned long long)__float_as_uint(m2) << 32) | __float_as_uint(mt), __ATOMIC_RELAXED, __HIP_MEMORY_SCOPE_AGENT);
        }
        asm volatile("s_waitcnt vmcnt(0)" ::: "memory");
        if (lane == 0) __hip_atomic_fetch_add(cnt + 64 * u.pm, 1u, __ATOMIC_RELAXED, __HIP_MEMORY_SCOPE_AGENT);
        if (wid == 0) {
            bool dead = false; const unsigned long long t0 = __builtin_amdgcn_s_memrealtime(); const unsigned want = 8u * (unsigned)ntn;
            for (;;) {
#if defined(BROKEN_EXCHANGE_NO_WAIT)
                break;
#endif
                if ((unsigned)__builtin_amdgcn_readfirstlane(__hip_atomic_load(cnt + 64 * u.pm, __ATOMIC_RELAXED, __HIP_MEMORY_SCOPE_AGENT)) >= want) break;
                if (__builtin_amdgcn_s_memrealtime() - t0 > 2000000ull) {
                    if (lane == 0) { unsigned expect = 0u; __hip_atomic_compare_exchange_strong(tmo + 1, &expect, code | (unsigned)(u.pm & 0xff), __ATOMIC_RELAXED, __ATOMIC_RELAXED, __HIP_MEMORY_SCOPE_AGENT);
                                     __hip_atomic_store(tmo, 1u, __ATOMIC_RELAXED, __HIP_MEMORY_SCOPE_AGENT); }
                    dead = true; break; }
                __builtin_amdgcn_s_sleep(2);
            }
            __builtin_amdgcn_fence(__ATOMIC_ACQUIRE, "agent");
            if (lane == 0) flag[0] = dead ? 1u : 0u;
        }
        asm volatile("s_waitcnt vmcnt(0) lgkmcnt(0)" ::: "memory"); __builtin_amdgcn_s_barrier(); asm volatile("" ::: "memory");
        const bool bad = flag[0] != 0u;
        if (lane < 32) {
            const unsigned long long* slot = (const unsigned long long*)xbuf + (size_t)(u.pm * BM + row) * 4; float mt[4], m2[4]; float ms = 0.f;
#pragma unroll
            for (int t = 0; t < 4; ++t) { if (t < ntn) { const unsigned long long w = __hip_atomic_load(slot + t, __ATOMIC_RELAXED, __HIP_MEMORY_SCOPE_AGENT); mt[t] = __uint_as_float((unsigned)w); m2[t] = __uint_as_float((unsigned)(w >> 32)); } else { mt[t] = 0.f; m2[t] = 0.f; } ms += mt[t]; }
            const float mean = ms / (float)ntn; float q = 0.f;
#pragma unroll
            for (int t = 0; t < 4; ++t) if (t < ntn) { const float dm = mt[t] - mean; q += m2[t] + 256.0f * dm * dm; }
            S[row] = (f32x2v){mean, 1.0f / sqrtf(q / (256.0f * (float)ntn) + eps)};
        }
        asm volatile("s_waitcnt lgkmcnt(0)" ::: "memory"); __builtin_amdgcn_s_barrier(); asm volatile("" ::: "memory");
        return bad;
    }
};
struct EpiLnRes {
    static constexpr bool PERM = false, AFTER_DRAIN = true;
    const float* base; float* out; int ldc; const float* bias; PanelStats st; unsigned poison;
    __device__ __forceinline__ void fused(f32x4 (&acc)[2][2][4][2], const Unit& u, int wr, int wc, int fr, int fq, PG8_LAS unsigned char* lds, int wid, int lane) const {
        typedef float f32x2v __attribute__((ext_vector_type(2)));
        const PG8_LAS f32x2v* S = (const PG8_LAS f32x2v*)(lds + 8192);
        const int col0 = u.pn * BM + wc * 32 + 4 * fq;
#pragma unroll
        for (int bj = 0; bj < 2; ++bj)
#pragma unroll
            for (int n = 0; n < 2; ++n) { const f32x4 bv = bias ? *(const f32x4*)(bias + col0 + bj * HALF + n * 16) : (f32x4){0.f, 0.f, 0.f, 0.f};
#pragma unroll
                for (int ai = 0; ai < 2; ++ai)
#pragma unroll
                    for (int m = 0; m < 4; ++m) acc[ai][bj][m][n] += bv; }
        f32x4 pre[4][2][2];
#pragma unroll
        for (int m = 0; m < 4; ++m) { const size_t off = (size_t)(u.pm * BM + wr * 64 + m * 16 + fr) * ldc + col0;
#pragma unroll
            for (int bj = 0; bj < 2; ++bj)
#pragma unroll
                for (int n = 0; n < 2; ++n) pre[m][bj][n] = *(const f32x4*)(base + off + bj * HALF + n * 16); }
        const bool bad = st.run(acc, u, wr, wc, fr, fq, lds, wid, lane) || poison != 0u;
        const float qnan = __builtin_nanf("");
#pragma unroll
        for (int ai = 0; ai < 2; ++ai)
#pragma unroll
            for (int m = 0; m < 4; ++m) { const int r = ai * HALF + wr * 64 + m * 16 + fr; const f32x2v sr = S[r]; const size_t off = (size_t)(u.pm * BM + r) * ldc + col0;
#pragma unroll
                for (int bj = 0; bj < 2; ++bj)
#pragma unroll
                    for (int n = 0; n < 2; ++n) { const f32x4 bs = ai == 0 ? pre[m][bj][n] : *(const f32x4*)(base + off + bj * HALF + n * 16); f32x4 o = bs + (acc[ai][bj][m][n] - sr.x) * sr.y;
                        if (bad) o = (f32x4){qnan, qnan, qnan, qnan}; *(f32x4*)(out + off + bj * HALF + n * 16) = o; }
                if (m & 1) asm volatile("" ::: "memory"); }
    }
};
struct EpiLnResLn {
    static constexpr bool PERM = false, AFTER_DRAIN = true;
    const float* base; float* out; bf16_t* xn; int ldc; const float* bias; PanelStats st1, st2; unsigned poison;
    __device__ __forceinline__ void fused(f32x4 (&acc)[2][2][4][2], const Unit& u, int wr, int wc, int fr, int fq, PG8_LAS unsigned char* lds, int wid, int lane) const {
        typedef float f32x2v __attribute__((ext_vector_type(2))); typedef unsigned u32x2v __attribute__((ext_vector_type(2)));
        const PG8_LAS f32x2v* S = (const PG8_LAS f32x2v*)(lds + 8192);
        const int col0 = u.pn * BM + wc * 32 + 4 * fq;
#pragma unroll
        for (int bj = 0; bj < 2; ++bj)
#pragma unroll
            for (int n = 0; n < 2; ++n) { const f32x4 bv = bias ? *(const f32x4*)(bias + col0 + bj * HALF + n * 16) : (f32x4){0.f, 0.f, 0.f, 0.f};
#pragma unroll
                for (int ai = 0; ai < 2; ++ai)
#pragma unroll
                    for (int m = 0; m < 4; ++m) acc[ai][bj][m][n] += bv; }
        bool bad = st1.run(acc, u, wr, wc, fr, fq, lds, wid, lane) || poison != 0u;
        const float qnan = __builtin_nanf("");
#pragma unroll
        for (int ai = 0; ai < 2; ++ai)
#pragma unroll
            for (int m = 0; m < 4; ++m) { const int r = ai * HALF + wr * 64 + m * 16 + fr; const f32x2v sr = S[r]; const size_t off = (size_t)(u.pm * BM + r) * ldc + col0;
#pragma unroll
                for (int bj = 0; bj < 2; ++bj)
#pragma unroll
                    for (int n = 0; n < 2; ++n) { const f32x4 bs = *(const f32x4*)(base + off + bj * HALF + n * 16); acc[ai][bj][m][n] = bs + (acc[ai][bj][m][n] - sr.x) * sr.y; }
                asm volatile("" : "+v"(acc[ai][0][m][0]), "+v"(acc[ai][0][m][1]), "+v"(acc[ai][1][m][0]), "+v"(acc[ai][1][m][1]));
                if (m & 1) asm volatile("" ::: "memory"); }
        const bool bad1 = bad;
        bad = st2.run(acc, u, wr, wc, fr, fq, lds, wid, lane) || bad;
#pragma unroll
        for (int ai = 0; ai < 2; ++ai)
#pragma unroll
            for (int m = 0; m < 4; ++m) { const int r = ai * HALF + wr * 64 + m * 16 + fr; const f32x2v sr = S[r]; const size_t off = (size_t)(u.pm * BM + r) * ldc + col0;
#pragma unroll
                for (int bj = 0; bj < 2; ++bj)
#pragma unroll
                    for (int n = 0; n < 2; ++n) { const f32x4 x1 = acc[ai][bj][m][n]; *(f32x4*)(out + off + bj * HALF + n * 16) = bad1 ? (f32x4){qnan, qnan, qnan, qnan} : x1;
                        const f32x4 o = (x1 - sr.x) * sr.y; u32x2v w; w.x = cvt_pk_bf16(o[0], o[1]); w.y = cvt_pk_bf16(o[2], o[3]);
                        if (bad) { w.x = 0x7fc07fc0u; w.y = 0x7fc07fc0u; } *(u32x2v*)(xn + off + bj * HALF + n * 16) = w; }
                asm volatile("" ::: "memory"); }
    }
};

template <class Epi, class Sched, bool ALIGN_EPI = false, bool SP2 = false>
__device__ __forceinline__ void gemm_phase(PG8_LAS unsigned char* lds, const Gemm g, const Sched& S, const Epi& E) {
    const int tid = opaque_tid(), wid = __builtin_amdgcn_readfirstlane(tid >> 6), lane = tid & 63, wr = wid >> 2, wc = wid & 3, fr = lane & 15, fq = lane >> 4;
    const int K = g.K, nt = K / BK;
    unsigned voffA[2], voffB[2];
#pragma unroll
    for (int i = 0; i < 2; ++i) { int R, C; stage_rc(tid * 16 + i * 8192, R, C); const int Rb = Epi::PERM ? ((R & ~31) + perm32(R & 31)) : R;
        voffA[i] = (unsigned)(R * K + C) * 2u; voffB[i] = (unsigned)(Rb * K + C) * 2u; }
    const size_t kstep = (size_t)(BK * 2);
    const size_t hstep = (size_t)HALF * K * 2;
    const size_t tstep = 2 * hstep;
    const unsigned ldsw = (unsigned)wid * 1024u;
    const int aoff = lds_byte(wr * 64 + fr, fq * 8), boff = lds_byte(wc * 32 + fr, fq * 8);
#define PG8_SA(b, h) (((b) * 2 + (h)) * HTB)
#define PG8_SB(b, h) ((4 + (b) * 2 + (h)) * HTB)
#define PG8_STAGE(bufoff, gbase, voff) do { _Pragma("unroll") for (int _i = 0; _i < 2; ++_i) \
        __builtin_amdgcn_global_load_lds((const unsigned*)((const char*)(gbase) + (voff)[_i]), (PG8_LAS unsigned*)(lds + (bufoff) + ldsw + _i * 8192), 16, 0, 0); } while (0)
#define PG8_LDA(dst, b, h) do { _Pragma("unroll") for (int m = 0; m < 4; ++m) _Pragma("unroll") for (int k = 0; k < 2; ++k) dst[m][k] = *(const PG8_LAS bf16x8*)(lds + PG8_SA(b, h) + aoff + m * 2048 + k * 1024); } while (0)
#define PG8_LDB(dst, b, h) do { _Pragma("unroll") for (int n = 0; n < 2; ++n) _Pragma("unroll") for (int k = 0; k < 2; ++k) dst[n][k] = *(const PG8_LAS bf16x8*)(lds + PG8_SB(b, h) + boff + n * 2048 + k * 1024); } while (0)
#define PG8_MMA(ai, bj, At, Bt) do { __builtin_amdgcn_s_setprio(1); _Pragma("unroll") for (int m = 0; m < 4; ++m) _Pragma("unroll") for (int n = 0; n < 2; ++n) _Pragma("unroll") for (int k = 0; k < 2; ++k) \
        acc[ai][bj][m][n] = __builtin_amdgcn_mfma_f32_16x16x32_bf16(Bt[n][k], At[m][k], acc[ai][bj][m][n], 0, 0, 0); __builtin_amdgcn_s_setprio(0); } while (0)
#define PG8_WAIT_V(n) asm volatile("s_waitcnt vmcnt(" #n ")" ::: "memory")
#define PG8_WAIT_L(n) asm volatile("s_waitcnt lgkmcnt(" #n ")" ::: "memory")
#define PG8_BAR __builtin_amdgcn_s_barrier()
#define PG8_SCHED __builtin_amdgcn_sched_barrier(0)
    Unit cur, nxt; int ui = 0;
    if (!S.next(0, cur)) return;
    f32x4 acc[2][2][4][2];
#pragma unroll
    for (int a = 0; a < 2; ++a)
#pragma unroll
        for (int b = 0; b < 2; ++b)
#pragma unroll
            for (int m = 0; m < 4; ++m)
#pragma unroll
                for (int n = 0; n < 2; ++n) acc[a][b][m][n] = (f32x4){0.f, 0.f, 0.f, 0.f};
    bf16x8 At[4][2], B0[2][2], B1[2][2];
    const char* cA = (const char*)g.A + (size_t)cur.pm * tstep; const char* cB = (const char*)g.Bt + (size_t)cur.pn * tstep;
    S.a_ready(cur);
    if constexpr (SP2) {
        PG8_STAGE(PG8_SB(0, 0), cB, voffB); PG8_STAGE(PG8_SB(0, 1), cB + hstep, voffB); PG8_STAGE(PG8_SA(0, 0), cA, voffA); PG8_STAGE(PG8_SA(0, 1), cA + hstep, voffA);
        if (wr == 1) PG8_BAR;
        PG8_WAIT_V(2); PG8_BAR;
        PG8_STAGE(PG8_SB(1, 0), cB + kstep, voffB); PG8_STAGE(PG8_SA(1, 0), cA + kstep, voffA); PG8_STAGE(PG8_SB(1, 1), cB + hstep + kstep, voffB);
        PG8_WAIT_V(6); PG8_BAR;
    } else {
        PG8_STAGE(PG8_SB(0, 0), cB, voffB); PG8_STAGE(PG8_SA(0, 0), cA, voffA); PG8_STAGE(PG8_SB(0, 1), cB + hstep, voffB); PG8_STAGE(PG8_SA(0, 1), cA + hstep, voffA);
        if (wr == 1) PG8_BAR;
        PG8_WAIT_V(4); PG8_BAR;
        PG8_STAGE(PG8_SB(1, 0), cB + kstep, voffB); PG8_STAGE(PG8_SA(1, 0), cA + kstep, voffA); PG8_STAGE(PG8_SB(1, 1), cB + hstep + kstep, voffB);
        PG8_WAIT_V(6); PG8_BAR;
    }
    for (;;) {
        const bool has_next = S.next(ui + 1, nxt);
        const char* nA = has_next ? (const char*)g.A + (size_t)nxt.pm * tstep : cA; const char* nB = has_next ? (const char*)g.Bt + (size_t)nxt.pn * tstep : cB;
        for (int t = 0; t < nt; t += 2) {
            const bool last = (t == nt - 2);
            const char* a1 = cA + (size_t)(t + 1) * kstep;
            const char* a2 = last ? nA : cA + (size_t)(t + 2) * kstep; const char* b2 = last ? nB : cB + (size_t)(t + 2) * kstep;
            const char* a3 = a2 + kstep; const char* b3 = b2 + kstep;
            if (last && has_next) S.a_ready(nxt);
            if constexpr (SP2) {
            PG8_LDB(B0, 0, 0); PG8_LDB(B1, 0, 1); PG8_SCHED; PG8_LDA(At, 0, 0); PG8_STAGE(PG8_SA(1, 1), a1 + hstep, voffA);
            PG8_WAIT_V(8); PG8_WAIT_L(0); PG8_BAR; PG8_MMA(0, 0, At, B0); PG8_MMA(0, 1, At, B1); PG8_BAR; PG8_SCHED;
            PG8_LDA(At, 0, 1); PG8_STAGE(PG8_SB(0, 0), b2, voffB); PG8_STAGE(PG8_SB(0, 1), b2 + hstep, voffB); PG8_STAGE(PG8_SA(0, 0), a2, voffA);
            PG8_WAIT_V(8); PG8_WAIT_L(0); PG8_BAR; PG8_MMA(1, 0, At, B0); PG8_MMA(1, 1, At, B1); PG8_BAR; PG8_SCHED;
            PG8_LDB(B0, 1, 0); PG8_LDB(B1, 1, 1); PG8_SCHED; PG8_LDA(At, 1, 0); PG8_STAGE(PG8_SA(0, 1), a2 + hstep, voffA);
            PG8_WAIT_V(8); PG8_WAIT_L(0); PG8_BAR; PG8_MMA(0, 0, At, B0); PG8_MMA(0, 1, At, B1); PG8_BAR; PG8_SCHED;
            PG8_LDA(At, 1, 1); PG8_STAGE(PG8_SB(1, 0), b3, voffB); PG8_STAGE(PG8_SB(1, 1), b3 + hstep, voffB); PG8_STAGE(PG8_SA(1, 0), a3, voffA);
            PG8_WAIT_V(8); PG8_WAIT_L(0); PG8_BAR; PG8_MMA(1, 0, At, B0); PG8_MMA(1, 1, At, B1); PG8_BAR; PG8_SCHED;
            } else {
            PG8_LDB(B0, 0, 0); PG8_SCHED; PG8_LDA(At, 0, 0); PG8_STAGE(PG8_SA(1, 1), a1 + hstep, voffA);
            PG8_WAIT_L(8); PG8_BAR; PG8_WAIT_L(0); PG8_MMA(0, 0, At, B0); PG8_BAR; PG8_SCHED;
            PG8_LDB(B1, 0, 1); PG8_STAGE(PG8_SB(0, 0), b2, voffB);
            PG8_BAR; PG8_WAIT_L(0); PG8_MMA(0, 1, At, B1); PG8_BAR;
            PG8_LDA(At, 0, 1); PG8_STAGE(PG8_SA(0, 0), a2, voffA);
            PG8_BAR; PG8_WAIT_L(0); PG8_MMA(1, 0, At, B0); PG8_BAR; PG8_SCHED;
            PG8_STAGE(PG8_SB(0, 1), b2 + hstep, voffB);
            PG8_WAIT_V(6); PG8_BAR; PG8_MMA(1, 1, At, B1); PG8_BAR;
            PG8_LDB(B0, 1, 0); PG8_SCHED; PG8_LDA(At, 1, 0); PG8_STAGE(PG8_SA(0, 1), a2 + hstep, voffA);
            PG8_WAIT_L(8); PG8_BAR; PG8_WAIT_L(0); PG8_MMA(0, 0, At, B0); PG8_BAR; PG8_SCHED;
            PG8_LDB(B1, 1, 1); PG8_STAGE(PG8_SB(1, 0), b3, voffB);
            PG8_BAR; PG8_WAIT_L(0); PG8_MMA(0, 1, At, B1); PG8_BAR;
            PG8_LDA(At, 1, 1); PG8_STAGE(PG8_SA(1, 0), a3, voffA);
            PG8_BAR; PG8_WAIT_L(0); PG8_MMA(1, 0, At, B0); PG8_BAR; PG8_SCHED;
            PG8_STAGE(PG8_SB(1, 1), b3 + hstep, voffB);
            PG8_WAIT_V(6); PG8_BAR; PG8_MMA(1, 1, At, B1); PG8_BAR;
            }
        }
        if constexpr (ALIGN_EPI) { if (wr == 0) PG8_BAR; }
        if constexpr (!Epi::AFTER_DRAIN) { E(acc, cur, wr, wc, fr, fq); S.done(cur); }
        if (!has_next) break;
#pragma unroll
        for (int a = 0; a < 2; ++a)
#pragma unroll
            for (int b = 0; b < 2; ++b)
#pragma unroll
                for (int m = 0; m < 4; ++m)
#pragma unroll
                    for (int n = 0; n < 2; ++n) acc[a][b][m][n] = (f32x4){0.f, 0.f, 0.f, 0.f};
        cur = nxt; cA = nA; cB = nB; ++ui;
        if constexpr (ALIGN_EPI) { if (wr == 1) PG8_BAR; }
    }
    PG8_WAIT_V(0);
    if constexpr (!ALIGN_EPI) { if (wr == 0) PG8_BAR; }
    PG8_BAR;
    if constexpr (Epi::AFTER_DRAIN) { E.fused(acc, cur, wr, wc, fr, fq, lds, wid, lane); S.done(cur); }
#undef PG8_SA
#undef PG8_SB
#undef PG8_STAGE
#undef PG8_LDA
#undef PG8_LDB
#undef PG8_MMA
#undef PG8_WAIT_V
#undef PG8_WAIT_L
#undef PG8_BAR
#undef PG8_SCHED
}
}
#define GAS __attribute__((address_space(1)))
#define LAS __attribute__((address_space(3)))
typedef unsigned short bf16;
typedef unsigned v4u __attribute__((ext_vector_type(4)));
typedef float f32x4 __attribute__((ext_vector_type(4)));
typedef short bf16x8 __attribute__((ext_vector_type(8)));
typedef GAS unsigned gu32;
typedef GAS unsigned long long gu64;
#define RLX_AGENT __ATOMIC_RELAXED, __HIP_MEMORY_SCOPE_AGENT
#define LDS_WAIT() asm volatile("s_waitcnt lgkmcnt(0)" ::: "memory")
#define VM_WAIT() asm volatile("s_waitcnt vmcnt(0)" ::: "memory")
__device__ __forceinline__ unsigned long long rt() { return __builtin_amdgcn_s_memrealtime(); }
__device__ __forceinline__ unsigned f2bf(float f) { unsigned u = __builtin_bit_cast(unsigned, f); return (u + 0x7fffu + ((u >> 16) & 1u)) >> 16; }
__device__ __forceinline__ unsigned pk2(float lo, float hi) { return f2bf(lo) | (f2bf(hi) << 16); }

#define XB_TMO      128
#define XB_XCNT(j)  (256  + 64 * (j))
#define XB_XSUB(j)  (1280 + 64 * (j))
#define XB_XGEN(j)  (2304 + 64 * (j))
#define XB_TOP      3328
#define XB_TOPGEN   3392
#define XCD_BAR_WORDS 3456
#define XB_SPIN_CAP (1u << 18)

__device__ __forceinline__ unsigned xb_ld(unsigned* p)              { return __hip_atomic_load(p, __ATOMIC_RELAXED, __HIP_MEMORY_SCOPE_AGENT); }
__device__ __forceinline__ unsigned xb_add(unsigned* p, unsigned v) { return __hip_atomic_fetch_add(p, v, __ATOMIC_RELAXED, __HIP_MEMORY_SCOPE_AGENT); }
__device__ __forceinline__ unsigned xb_xcc_id() { return (unsigned)__builtin_amdgcn_s_getreg((3 << 11) | 20) & 0xFu; }
#define XB_SPIN(cond, bar) do { unsigned _sp = 0; while (cond) { __builtin_amdgcn_s_sleep(1); \
    if ((++_sp & 255u) == 0u) { if (xb_ld(&(bar)[XB_TMO])) break; if (_sp > XB_SPIN_CAP) { atomicAdd(&(bar)[XB_TMO], 1u); break; } } } } while (0)

struct XcdBarrier {
    unsigned* bar; unsigned x;
    volatile LAS unsigned* st;
};

__device__ __forceinline__ XcdBarrier xcd_barrier_post(unsigned* bar, volatile LAS unsigned* st) {
    XcdBarrier b; b.bar = bar; b.x = xb_xcc_id(); b.st = st;
    if (threadIdx.x == 0) (void)xb_add(&bar[XB_XCNT(b.x)], 1u);
    return b;
}
__device__ __forceinline__ void xcd_barrier_complete(unsigned* bar, unsigned x, unsigned& nloc, unsigned& nx) {
    const unsigned G = gridDim.x * gridDim.y * gridDim.z;
    unsigned sum, cnt, mine, sp = 0u;
    for (;;) {
        sum = 0u; cnt = 0u; mine = 0u;
#pragma unroll
        for (unsigned j = 0; j < 16; ++j) { const unsigned c = xb_ld(&bar[XB_XCNT(j)]); sum += c; cnt += (c > 0u) ? 1u : 0u; mine = (j == x) ? c : mine; }
        if (sum == G) break;
        __builtin_amdgcn_s_sleep(1);
        if ((++sp & 255u) == 0u) { if (xb_ld(&bar[XB_TMO])) break; if (sp > XB_SPIN_CAP) { atomicAdd(&bar[XB_TMO], 1u); break; } }
    }
    nloc = mine > 0u ? mine : 1u; nx = cnt > 0u ? cnt : 1u;
}

__device__ __forceinline__ void xcd_barrier(const XcdBarrier& b) {
    asm volatile("s_waitcnt vmcnt(0)" ::: "memory");
    __syncthreads();
    if (threadIdx.x == 0) {
        unsigned* bar = b.bar;
        __builtin_amdgcn_s_waitcnt(0);
        unsigned nloc = b.st[0], nx = b.st[1];
        if (nloc == 0u) { xcd_barrier_complete(bar, b.x, nloc, nx); b.st[0] = nloc; b.st[1] = nx; }
        const unsigned old = xb_add(&bar[XB_XSUB(b.x)], 1u);
        const unsigned gen = old / nloc;
        if (old + 1u == (gen + 1u) * nloc) {
            __builtin_amdgcn_fence(__ATOMIC_RELEASE, "agent");
            asm volatile("s_waitcnt vmcnt(0)" ::: "memory");
            const unsigned og = xb_add(&bar[XB_TOP], 1u);
            const unsigned tg = og / nx;
            if (og + 1u == (tg + 1u) * nx) xb_add(&bar[XB_TOPGEN], 1u);
            else XB_SPIN(xb_ld(&bar[XB_TOPGEN]) == tg, bar);
            __builtin_amdgcn_fence(__ATOMIC_ACQUIRE, "agent");
            xb_add(&bar[XB_XGEN(b.x)], 1u);
            asm volatile("s_waitcnt vmcnt(0)" ::: "memory");
        } else {
            XB_SPIN(xb_ld(&bar[XB_XGEN(b.x)]) == gen, bar);
            __builtin_amdgcn_fence(__ATOMIC_ACQUIRE, "agent");
            asm volatile("s_waitcnt vmcnt(0)" ::: "memory");
        }
    }
    __syncthreads();
}

namespace cg = cooperative_groups;
constexpr int NWAVES = 8, NTHR = 512;
constexpr int BATCH = 8, SEQ = 2048, DM = 1024, M = BATCH * SEQ, DEPTH = 4;
constexpr int INW = 3072, QW = 2048, NEXP = 16384, NSEL = 128;
constexpr float ALPHA = 1.6817928305074292f;
constexpr float LN_EPS = 1e-5f, RMS_EPS = 1e-5f;
constexpr float LOG2E = 1.4426950408889634f;
constexpr float QSCALE = 0.125f * LOG2E;
typedef float f32x16 __attribute__((ext_vector_type(16)));
typedef short s16x4 __attribute__((ext_vector_type(4)));
typedef float f32x2_t __attribute__((ext_vector_type(2)));
typedef __bf16 bf16x2_t __attribute__((ext_vector_type(2)));
typedef unsigned v2u __attribute__((ext_vector_type(2)));

constexpr size_t MiB = 1u << 20;
constexpr size_t WS_CTL = 0, CTL_ZERO_BYTES = 1 * MiB;
constexpr size_t WS_WIN = 2 * MiB;
constexpr size_t WS_WO = 26 * MiB;
constexpr size_t WS_WQ = 34 * MiB;
constexpr size_t WS_SK = 50 * MiB;
constexpr size_t WS_EU = 64 * MiB;
constexpr size_t WS_EV = 192 * MiB;
constexpr size_t WS_HB = 320 * MiB;
constexpr size_t WS_H1B = 352 * MiB;
constexpr size_t WS_PROJ = 384 * MiB;
constexpr size_t WS_MIX = 480 * MiB;
constexpr size_t WS_Z = 512 * MiB;
constexpr size_t WS_H1 = 576 * MiB;
constexpr size_t WS_QP = 640 * MiB;
constexpr size_t WS_IDX = 704 * MiB;
constexpr size_t WS_GATE = 712 * MiB;
constexpr size_t WS_END = 720 * MiB;
constexpr int CW_BAR = 4096;

constexpr int RING_BYTES = 131072;
constexpr int LDSCTL_OFF = RING_BYTES, MISC_OFF = LDSCTL_OFF + 320;
constexpr int LDS_BYTES = 147456;

__device__ __forceinline__ unsigned cvtpk(float lo, float hi) { f32x2_t v = {lo, hi}; bf16x2_t b = __builtin_convertvector(v, bf16x2_t); return __builtin_bit_cast(unsigned, b); }
__device__ __forceinline__ float bf_lo(unsigned w) { return __builtin_bit_cast(float, w << 16); }
__device__ __forceinline__ float bf_hi(unsigned w) { return __builtin_bit_cast(float, w & 0xffff0000u); }
__device__ __forceinline__ float wave_sum(float v) {
#pragma unroll
    for (int o = 1; o < 64; o <<= 1) v += __shfl_xor(v, o);
    return v;
}
__device__ __forceinline__ int crow(int r, int hi) { return (r & 3) + 8 * (r >> 2) + 4 * hi; }

namespace pg8 {
struct EpiProj {
    static constexpr bool PERM = true, AFTER_DRAIN = false;
    bf16_t* O; float qs;
    __device__ __forceinline__ void operator()(const f32x4 (&acc)[2][2][4][2], const Unit& u, int wr, int wc, int fr, int fq) const {
        const int row0 = u.pm * BM + wr * 64 + fr, col0 = u.pn * BM + wc * 32 + 8 * fq, reg = u.pn >> 1;
        const float sc = (reg == 0 || reg == 3) ? qs : 1.0f;
#pragma unroll
        for (int ai = 0; ai < 2; ++ai)
#pragma unroll
            for (int m = 0; m < 4; ++m) { bf16_t* rowp = O + (size_t)(row0 + ai * HALF + m * 16) * 3072 + col0;
#pragma unroll
                for (int bj = 0; bj < 2; ++bj) { const f32x4 v0 = acc[ai][bj][m][0] * sc, v1 = acc[ai][bj][m][1] * sc;
                    u32x4 w; w.x = cvt_pk_bf16(v0[0], v0[1]); w.y = cvt_pk_bf16(v0[2], v0[3]); w.z = cvt_pk_bf16(v1[0], v1[1]); w.w = cvt_pk_bf16(v1[2], v1[3]);
                    *(u32x4*)(rowp + bj * HALF) = w; } }
    }
};
struct EpiResid {
    static constexpr bool PERM = false, AFTER_DRAIN = false;
    const float* base; float* out; float alpha;
    __device__ __forceinline__ void operator()(const f32x4 (&acc)[2][2][4][2], const Unit& u, int wr, int wc, int fr, int fq) const {
        const int col0 = u.pn * BM + wc * 32 + 4 * fq;
#pragma unroll
        for (int ai = 0; ai < 2; ++ai)
#pragma unroll
            for (int m = 0; m < 4; ++m) { const size_t off = (size_t)(u.pm * BM + ai * HALF + wr * 64 + m * 16 + fr) * 1024 + col0;
#pragma unroll
                for (int bj = 0; bj < 2; ++bj)
#pragma unroll
                    for (int n = 0; n < 2; ++n) { const f32x4 bs = *(const f32x4*)(base + off + bj * HALF + n * 16);
                        *(f32x4*)(out + off + bj * HALF + n * 16) = bs * alpha + acc[ai][bj][m][n]; } }
    }
};
}

__device__ __forceinline__ void p0_transpose_item(const float* W, int K, int N, bf16* WT, LAS float* scr, int item, int lane) {
    const int nblk = N / 32, kb = item / nblk, nb = item % nblk, k0 = 64 * kb, n0 = 32 * nb;
#pragma unroll 8
    for (int i = 0; i < 32; ++i) { const int kk = 2 * i + (lane >> 5); scr[kk * 33 + (lane & 31)] = W[(size_t)(k0 + kk) * N + n0 + (lane & 31)]; }
    LDS_WAIT(); asm volatile("" ::: "memory");
    const int c = lane & 7;
#pragma unroll
    for (int j = 0; j < 4; ++j) { const int n = (lane >> 3) + 8 * j; const LAS float* s = scr + (8 * c) * 33 + n;
        v4u o; o.x = cvtpk(s[0 * 33], s[1 * 33]); o.y = cvtpk(s[2 * 33], s[3 * 33]); o.z = cvtpk(s[4 * 33], s[5 * 33]); o.w = cvtpk(s[6 * 33], s[7 * 33]);
        *(GAS v4u*)(WT + (size_t)(n0 + n) * K + k0 + 8 * c) = o; }
    LDS_WAIT(); asm volatile("" ::: "memory");
}
__device__ __forceinline__ void cvt_stream(const float* src, bf16* dst, size_t n8, size_t gtid, size_t gthreads) {
    for (size_t c = gtid; c < n8; c += gthreads) {
        const f32x4 a = ((const GAS f32x4*)src)[2 * c], b = ((const GAS f32x4*)src)[2 * c + 1];
        v4u o; o.x = cvtpk(a.x, a.y); o.y = cvtpk(a.z, a.w); o.z = cvtpk(b.x, b.y); o.w = cvtpk(b.z, b.w);
        ((GAS v4u*)dst)[c] = o;
    }
}

struct Args { const float* in[16]; float* out; unsigned char* ws; int ph_lo, ph_hi; };

__device__ __forceinline__ void phase_prologue(const Args& a, LAS unsigned char* lds, int vcu, int G, int wave, int lane) {
    unsigned char* ws = a.ws;
    LAS float* scr = (LAS float*)(lds + wave * 16384);
    const int gw = vcu * NWAVES + wave, NGW = G * NWAVES;
    constexpr int I_IN = (DM / 64) * (INW / 32), I_O = (DM / 64) * (DM / 32), I_Q = (DM / 64) * (QW / 32), I_L = I_IN + I_O + I_Q;
    for (int it = gw; it < DEPTH * I_L; it += NGW) {
        const int l = it / I_L; int r = it % I_L;
        if (r < I_IN) { p0_transpose_item(a.in[1] + (size_t)l * DM * INW, DM, INW, (bf16*)(ws + WS_WIN) + (size_t)l * INW * DM, scr, r, lane); continue; } r -= I_IN;
        if (r < I_O) { p0_transpose_item(a.in[7] + (size_t)l * DM * DM, DM, DM, (bf16*)(ws + WS_WO) + (size_t)l * DM * DM, scr, r, lane); continue; } r -= I_O;
        p0_transpose_item(a.in[10] + (size_t)l * DM * QW, DM, QW, (bf16*)(ws + WS_WQ) + (size_t)l * QW * DM, scr, r, lane);
    }
    const size_t gtid = (size_t)vcu * NTHR + threadIdx.x, gthreads = (size_t)G * NTHR;
    cvt_stream(a.in[0], (bf16*)(ws + WS_HB), (size_t)M * DM / 8, gtid, gthreads);
    cvt_stream(a.in[11], (bf16*)(ws + WS_SK), (size_t)DEPTH * 8 * 2 * 128 * 128 / 8, gtid, gthreads);
    cvt_stream(a.in[12], (bf16*)(ws + WS_EU), (size_t)DEPTH * NEXP * DM / 8, gtid, gthreads);
    cvt_stream(a.in[13], (bf16*)(ws + WS_EV), (size_t)DEPTH * NEXP * DM / 8, gtid, gthreads);
}

__device__ __forceinline__ void phase_ln1(const float* Z, const float* g, const float* b, float* H1, bf16* H1B, int vcu, int G, int wave, int lane) {
    const int gw = vcu * NWAVES + wave, NGW = G * NWAVES;
    f32x4 gv[4], bv[4];
#pragma unroll
    for (int j = 0; j < 4; ++j) { gv[j] = ((const GAS f32x4*)g)[lane + 64 * j]; bv[j] = ((const GAS f32x4*)b)[lane + 64 * j]; }
    for (int m = gw; m < M; m += NGW) {
        const GAS f32x4* xr = (const GAS f32x4*)(Z + (size_t)m * DM) + lane;
        f32x4 v[4]; float s = 0.f;
#pragma unroll
        for (int j = 0; j < 4; ++j) { v[j] = xr[64 * j]; s += (v[j].x + v[j].y) + (v[j].z + v[j].w); }
        const float mean = wave_sum(s) * (1.f / DM); float s2 = 0.f;
#pragma unroll
        for (int j = 0; j < 4; ++j) { v[j] = v[j] - mean; s2 += (v[j].x * v[j].x + v[j].y * v[j].y) + (v[j].z * v[j].z + v[j].w * v[j].w); }
        const float rstd = 1.f / sqrtf(wave_sum(s2) * (1.f / DM) + LN_EPS);
        GAS f32x4* o4 = (GAS f32x4*)(H1 + (size_t)m * DM) + lane;
        GAS v2u* o2 = (GAS v2u*)(H1B + (size_t)m * DM) + lane;
#pragma unroll
        for (int j = 0; j < 4; ++j) { const f32x4 y = v[j] * rstd * gv[j] + bv[j]; o4[64 * j] = y; v2u w; w.x = cvtpk(y.x, y.y); w.y = cvtpk(y.z, y.w); o2[64 * j] = w; }
    }
}

namespace att {
typedef short v4i16_t __attribute__((ext_vector_type(4)));
constexpr int KP = 144;
constexpr int D_V = 2 * 64 * KP, D_BUF = D_V + 16384;
constexpr int S_V = 64 * KP, S_BUF = S_V + 8192;
__device__ __forceinline__ s16x4 vtr(const LAS unsigned char* p) { return __builtin_bit_cast(s16x4, __builtin_amdgcn_ds_read_tr16_b64_v4i16((LAS v4i16_t*)p)); }
__device__ __forceinline__ float swapsum(float v) { auto rr = __builtin_amdgcn_permlane32_swap(__float_as_uint(v), __float_as_uint(v), false, false); return __uint_as_float(rr[0]) + __uint_as_float(rr[1]); }
__device__ __forceinline__ float swapmax(float v) { auto rr = __builtin_amdgcn_permlane32_swap(__float_as_uint(v), __float_as_uint(v), false, false); return fmaxf(__uint_as_float(rr[0]), __uint_as_float(rr[1])); }
#define ATT_MFMA(a, b, c) __builtin_amdgcn_mfma_f32_32x32x16_bf16((a), (b), (c), 0, 0, 0)
#define ATT_PF(S, s) (bf16x8)__builtin_bit_cast(bf16x8, ((v4u){cvtpk(S[8 * (s)], S[8 * (s) + 1]), cvtpk(S[8 * (s) + 2], S[8 * (s) + 3]), cvtpk(S[8 * (s) + 4], S[8 * (s) + 5]), cvtpk(S[8 * (s) + 6], S[8 * (s) + 7])}))

__device__ __forceinline__ void diff_unit(LAS unsigned char* lds, const bf16* proj, bf16* mix, int b, int h, int qt, float lam, float sl2, const float* subg, float gscale) {
    const int tid = opaque_tid(), lane = tid & 63, r32 = lane & 31, hi = lane >> 5;
    const int wid = __builtin_amdgcn_readfirstlane(tid >> 6), mp = wid >> 2, qs = wid & 3;
    const size_t rowbase = (size_t)b * SEQ;
    const int tq = 128 * qt + 32 * qs + r32;
    bf16x8 qf[4];
    { const bf16* Qp = proj + (rowbase + tq) * INW + h * 128 + mp * 64 + 8 * hi;
#pragma unroll
      for (int s = 0; s < 4; ++s) qf[s] = *(const GAS bf16x8*)(Qp + 16 * s); }
    const int krow = tid >> 3, kch = tid & 7, vrow = tid >> 4, vch = tid & 15;
    const bf16* ksrc = proj + (rowbase + krow) * INW + 512 + h * 128 + kch * 8;
    const bf16* vsrc = proj + (rowbase + vrow) * INW + 1024 + h * 128 + vch * 8;
    const int kdst = krow * KP + kch * 16;
    const int vdst = ((vrow >> 3) * 4 + (vch >> 2)) * 512 + (vrow & 7) * 64 + (vch & 3) * 16;
    const int NT = 2 * qt + 2;
    v4u sk1, sk2, sv0, sv1;
#define DLOAD(kt) do { const size_t o_ = (size_t)(kt) * 64 * INW; sk1 = *(const GAS v4u*)(ksrc + o_); sk2 = *(const GAS v4u*)(ksrc + o_ + 64); \
        sv0 = *(const GAS v4u*)(vsrc + o_); sv1 = *(const GAS v4u*)(vsrc + o_ + (size_t)32 * INW); } while (0)
#define DWRITE(buf) do { LAS unsigned char* p_ = lds + (buf) * D_BUF; *(LAS v4u*)(p_ + kdst) = sk1; *(LAS v4u*)(p_ + 64 * KP + kdst) = sk2; \
        *(LAS v4u*)(p_ + D_V + vdst) = sv0; *(LAS v4u*)(p_ + D_V + 8192 + vdst) = sv1; } while (0)
    DLOAD(0); DWRITE(0); __syncthreads();
    float mhat = -1e30f, lsum = 0.f;
    f32x16 O[4];
#pragma unroll
    for (int d = 0; d < 4; ++d) O[d] = (f32x16){};
    for (int kt = 0; kt < NT; ++kt) {
        const int cur = kt & 1;
        if (kt + 1 < NT) DLOAD(kt + 1);
        if (!(kt == NT - 1 && qs < 2)) {
            const LAS unsigned char* Kb = lds + cur * D_BUF + mp * (64 * KP) + r32 * KP + hi * 16;
            const LAS unsigned char* Vb = lds + cur * D_BUF + D_V + (4 * hi + ((lane & 15) >> 2)) * 64 + ((lane >> 4) & 1) * 32 + (lane & 3) * 8;
            f32x16 S0, S1;
            const float base0 = -sl2 * (float)(tq - 64 * kt - 4 * hi);
#pragma unroll
            for (int r = 0; r < 16; ++r) { const float c = (float)((r & 3) + 8 * (r >> 2)); S0[r] = fmaf(sl2, c, base0); S1[r] = fmaf(sl2, c + 32.f, base0); }
#pragma unroll
            for (int s = 0; s < 4; ++s) { const bf16x8 a0 = *(const LAS bf16x8*)(Kb + s * 32), a1 = *(const LAS bf16x8*)(Kb + 32 * KP + s * 32);
                S0 = ATT_MFMA(a0, qf[s], S0); S1 = ATT_MFMA(a1, qf[s], S1); }
            if (kt >= NT - 2) {
                const int kb = 64 * kt + 4 * hi;
#pragma unroll
                for (int r = 0; r < 16; ++r) { const int kv = kb + (r & 3) + 8 * (r >> 2); if (kv > tq) S0[r] = -INFINITY; if (kv + 32 > tq) S1[r] = -INFINITY; }
            }
            float rm = fmaxf(S0[0], S1[0]);
#pragma unroll
            for (int r = 1; r < 16; ++r) rm = fmaxf(rm, fmaxf(S0[r], S1[r]));
            rm = swapmax(rm);
            const float mnew = fmaxf(mhat, rm), f = __builtin_amdgcn_exp2f(mhat - mnew);
            mhat = mnew; lsum *= f;
#pragma unroll
            for (int d = 0; d < 4; ++d)
#pragma unroll
                for (int r = 0; r < 16; ++r) O[d][r] *= f;
            float ps = 0.f;
#pragma unroll
            for (int r = 0; r < 16; ++r) { S0[r] = __builtin_amdgcn_exp2f(S0[r] - mhat); S1[r] = __builtin_amdgcn_exp2f(S1[r] - mhat); ps += S0[r] + S1[r]; }
            lsum += ps;
            bf16x8 pf[4];
            pf[0] = ATT_PF(S0, 0); pf[1] = ATT_PF(S0, 1); pf[2] = ATT_PF(S1, 0); pf[3] = ATT_PF(S1, 1);
#pragma unroll
            for (int d = 0; d < 4; ++d)
#pragma unroll
                for (int ks = 0; ks < 4; ++ks) { const s16x4 lo = vtr(Vb + ((2 * ks) * 4 + d) * 512), up = vtr(Vb + ((2 * ks + 1) * 4 + d) * 512);
                    const bf16x8 vf = (bf16x8){lo[0], lo[1], lo[2], lo[3], up[0], up[1], up[2], up[3]};
                    O[d] = ATT_MFMA(vf, pf[ks], O[d]); }
        }
        if (kt + 1 < NT) DWRITE(cur ^ 1);
        __syncthreads();
    }
#undef DLOAD
#undef DWRITE
    lsum = swapsum(lsum);
    const float inv = 1.0f / lsum;
    LAS float* X = (LAS float*)lds;
    if (mp == 1) {
#pragma unroll
        for (int d = 0; d < 4; ++d)
#pragma unroll
            for (int r = 0; r < 16; ++r) X[(qs * 64 + d * 16 + r) * 64 + lane] = O[d][r] * inv;
    }
    __syncthreads();
    if (mp == 0) {
        float ss = 0.f;
#pragma unroll
        for (int d = 0; d < 4; ++d)
#pragma unroll
            for (int r = 0; r < 16; ++r) { const float v = O[d][r] * inv - lam * X[(qs * 64 + d * 16 + r) * 64 + lane]; O[d][r] = v; ss += v * v; }
        ss = swapsum(ss);
        const float rs = gscale / sqrtf(ss * (1.0f / 128.0f) + RMS_EPS);
        bf16* op = mix + (rowbase + tq) * DM + h * 128 + 4 * hi;
#pragma unroll
        for (int d = 0; d < 4; ++d)
#pragma unroll
            for (int g = 0; g < 4; ++g) { const int dv0 = 32 * d + 8 * g; const f32x4 gv = *(const GAS f32x4*)(subg + dv0 + 4 * hi);
                v2u w; w.x = cvtpk(O[d][4 * g] * rs * gv.x, O[d][4 * g + 1] * rs * gv.y); w.y = cvtpk(O[d][4 * g + 2] * rs * gv.z, O[d][4 * g + 3] * rs * gv.w);
                *(GAS v2u*)(op + dv0) = w; }
    }
    __syncthreads();
}

__device__ __forceinline__ void sb_unit(LAS unsigned char* lds, const bf16* proj, bf16* mix, int b, int g, int qt) {
    const int tid = opaque_tid(), lane = tid & 63, r32 = lane & 31, hi = lane >> 5;
    const int wid = __builtin_amdgcn_readfirstlane(tid >> 6);
    const size_t rowbase = (size_t)b * SEQ;
    const int tq = 256 * qt + 32 * wid + r32;
    bf16x8 qf[4];
    { const bf16* Qp = proj + (rowbase + tq) * INW + 1536 + g * 64 + 8 * hi;
#pragma unroll
      for (int s = 0; s < 4; ++s) qf[s] = *(const GAS bf16x8*)(Qp + 16 * s); }
    const int krow = tid >> 3, kch = tid & 7;
    const bf16* ksrc = proj + (rowbase + krow) * INW + 2048 + g * 64 + kch * 8;
    const bf16* vsrc = proj + (rowbase + krow) * INW + 2560 + g * 64 + kch * 8;
    const int kdst = krow * KP + kch * 16;
    const int vdst = ((krow >> 3) * 2 + (kch >> 2)) * 512 + (krow & 7) * 64 + (kch & 3) * 16;
    const int NT = 4 * qt + 4, ktw = 4 * qt + (wid >> 1);
    v4u sk, sv;
#define SLOAD(kt) do { const size_t o_ = (size_t)(kt) * 64 * INW; sk = *(const GAS v4u*)(ksrc + o_); sv = *(const GAS v4u*)(vsrc + o_); } while (0)
#define SWRITE(buf) do { LAS unsigned char* p_ = lds + (buf) * S_BUF; *(LAS v4u*)(p_ + kdst) = sk; *(LAS v4u*)(p_ + S_V + vdst) = sv; } while (0)
    SLOAD(NT - 1); SWRITE(0); __syncthreads();
    float c2 = 0.f;
    f32x16 O[2];
    O[0] = (f32x16){}; O[1] = (f32x16){};
    for (int i = 0; i < NT; ++i) {
        const int kt = NT - 1 - i, cur = i & 1;
        if (i + 1 < NT) SLOAD(kt - 1);
        if (kt <= ktw) {
            const LAS unsigned char* Kb = lds + cur * S_BUF + r32 * KP + hi * 16;
            const LAS unsigned char* Vb = lds + cur * S_BUF + S_V + (4 * hi + ((lane & 15) >> 2)) * 64 + ((lane >> 4) & 1) * 32 + (lane & 3) * 8;
            f32x16 S0 = (f32x16){}, S1 = (f32x16){};
#pragma unroll
            for (int s = 0; s < 4; ++s) { const bf16x8 a0 = *(const LAS bf16x8*)(Kb + s * 32), a1 = *(const LAS bf16x8*)(Kb + 32 * KP + s * 32);
                S0 = ATT_MFMA(a0, qf[s], S0); S1 = ATT_MFMA(a1, qf[s], S1); }
            const bool diag = (kt == ktw);
            const int kb = 64 * kt + 4 * hi;
            f32x16 x0, x1;
#pragma unroll
            for (int r = 0; r < 16; ++r) { x0[r] = -__builtin_amdgcn_logf(1.0f + __builtin_amdgcn_exp2f(S0[r])); x1[r] = -__builtin_amdgcn_logf(1.0f + __builtin_amdgcn_exp2f(S1[r])); }
            if (diag) {
#pragma unroll
                for (int r = 0; r < 16; ++r) { const int kv = kb + (r & 3) + 8 * (r >> 2); if (kv >= tq) x0[r] = 0.f; if (kv + 32 >= tq) x1[r] = 0.f; }
            }
#pragma unroll
            for (int gq = 0; gq < 4; ++gq) { const int i4 = 4 * gq;
                x0[i4 + 2] += x0[i4 + 3]; x0[i4 + 1] += x0[i4 + 2]; x0[i4] += x0[i4 + 1];
                x1[i4 + 2] += x1[i4 + 3]; x1[i4 + 1] += x1[i4 + 2]; x1[i4] += x1[i4 + 1]; }
            float run = c2;
#pragma unroll
            for (int gq = 3; gq >= 0; --gq) { auto rr = __builtin_amdgcn_permlane32_swap(__float_as_uint(x1[4 * gq]), __float_as_uint(x1[4 * gq]), false, false);
                const float lo = __uint_as_float(rr[0]), up = __uint_as_float(rr[1]); const float off = run + (hi == 0 ? up : 0.f); run += lo + up;
                x1[4 * gq] += off; x1[4 * gq + 1] += off; x1[4 * gq + 2] += off; x1[4 * gq + 3] += off; }
#pragma unroll
            for (int gq = 3; gq >= 0; --gq) { auto rr = __builtin_amdgcn_permlane32_swap(__float_as_uint(x0[4 * gq]), __float_as_uint(x0[4 * gq]), false, false);
                const float lo = __uint_as_float(rr[0]), up = __uint_as_float(rr[1]); const float off = run + (hi == 0 ? up : 0.f); run += lo + up;
                x0[4 * gq] += off; x0[4 * gq + 1] += off; x0[4 * gq + 2] += off; x0[4 * gq + 3] += off; }
            c2 = run;
#pragma unroll
            for (int r = 0; r < 16; ++r) { S0[r] = __builtin_amdgcn_exp2f(S0[r] + x0[r]); S1[r] = __builtin_amdgcn_exp2f(S1[r] + x1[r]); }
            if (diag) {
#pragma unroll
                for (int r = 0; r < 16; ++r) { const int kv = kb + (r & 3) + 8 * (r >> 2); if (kv >= tq) S0[r] = 0.f; if (kv + 32 >= tq) S1[r] = 0.f; }
            }
            bf16x8 pf[4];
            pf[0] = ATT_PF(S0, 0); pf[1] = ATT_PF(S0, 1); pf[2] = ATT_PF(S1, 0); pf[3] = ATT_PF(S1, 1);
#pragma unroll
            for (int d = 0; d < 2; ++d)
#pragma unroll
                for (int ks = 0; ks < 4; ++ks) { const s16x4 lo = vtr(Vb + ((2 * ks) * 2 + d) * 512), up = vtr(Vb + ((2 * ks + 1) * 2 + d) * 512);
                    const bf16x8 vf = (bf16x8){lo[0], lo[1], lo[2], lo[3], up[0], up[1], up[2], up[3]};
                    O[d] = ATT_MFMA(vf, pf[ks], O[d]); }
        }
        if (i + 1 < NT) SWRITE(cur ^ 1);
        __syncthreads();
    }
#undef SLOAD
#undef SWRITE
    bf16* op = mix + (rowbase + tq) * DM + 512 + g * 64 + 4 * hi;
#pragma unroll
    for (int d = 0; d < 2; ++d)
#pragma unroll
        for (int gq = 0; gq < 4; ++gq) { v2u w; w.x = cvtpk(O[d][4 * gq], O[d][4 * gq + 1]); w.y = cvtpk(O[d][4 * gq + 2], O[d][4 * gq + 3]);
            *(GAS v2u*)(op + 32 * d + 8 * gq) = w; }
}
#undef ATT_MFMA
#undef ATT_PF
}

__device__ __forceinline__ void phase_attention(const Args& a, int layer, LAS unsigned char* lds, int vcu, int lane) {
    const bf16* proj = (const bf16*)(a.ws + WS_PROJ); bf16* mix = (bf16*)(a.ws + WS_MIX);
    const float linit = 0.8f - 0.6f * expf(-0.3f * (float)layer);
    const float d1 = wave_sum(a.in[2][layer * 64 + lane] * a.in[3][layer * 64 + lane]);
    const float d2 = wave_sum(a.in[4][layer * 64 + lane] * a.in[5][layer * 64 + lane]);
    const float lam = expf(d1) - expf(d2) + linit;
    const float* subg = a.in[6] + layer * 128;
    {
        const int bh = vcu >> 3, s = vcu & 7, b = bh >> 2, h = bh & 3;
        const float sl2 = exp2f(-2.0f * (float)(h + 1)) * LOG2E;
#pragma nounroll
        for (int i = 0; i < 2; ++i) att::diff_unit(lds, proj, mix, b, h, i ? s : 15 - s, lam, sl2, subg, 1.0f - linit);
    }
    {
        const int bg = vcu >> 2, s = vcu & 3, b = bg >> 3, g = bg & 7;
#pragma nounroll
        for (int i = 0; i < 2; ++i) att::sb_unit(lds, proj, mix, b, g, i ? s : 7 - s);
    }
}

namespace peer {
constexpr int SKP = 272;
constexpr int L_CAND = 2 * 128 * SKP;
__device__ __forceinline__ unsigned f2mono(float f) { const unsigned u = __float_as_uint(f); return u ^ ((unsigned)((int)u >> 31) | 0x80000000u); }
__device__ __forceinline__ float mono2f(unsigned m) { const unsigned u = (m & 0x80000000u) ? (m ^ 0x80000000u) : ~m; return __uint_as_float(u); }
__device__ __forceinline__ float key_score(unsigned k) { return mono2f((k & ~127u) | 64u); }
__device__ __forceinline__ void sort16_desc(unsigned (&v)[16]) {
#pragma unroll
    for (int k = 2; k <= 16; k <<= 1)
#pragma unroll
        for (int j = k >> 1; j > 0; j >>= 1)
#pragma unroll
            for (int i = 0; i < 16; ++i) { const int p = i ^ j; if (p > i) { const bool desc = ((i & k) == 0); const unsigned a = v[i], b = v[p];
                const unsigned mx = a > b ? a : b, mn = a > b ? b : a; v[i] = desc ? mx : mn; v[p] = desc ? mn : mx; } }
}
__device__ __forceinline__ void merge16_desc(unsigned (&a)[16], const unsigned (&b)[16]) {
#pragma unroll
    for (int i = 0; i < 16; ++i) a[i] = a[i] > b[15 - i] ? a[i] : b[15 - i];
#pragma unroll
    for (int j = 8; j > 0; j >>= 1)
#pragma unroll
        for (int i = 0; i < 16; ++i) { const int p = i ^ j; if (p > i) { const unsigned x = a[i], y = a[p]; a[i] = x > y ? x : y; a[p] = x > y ? y : x; } }
}
__device__ __forceinline__ void score_unit(LAS unsigned char* lds, const bf16* qp, const bf16* skl, int* idxo, float* gateo, int tile, int h) {
    const int tid = opaque_tid(), lane = tid & 63, r32 = lane & 31, hi = lane >> 5;
    const int wid = __builtin_amdgcn_readfirstlane(tid >> 6), p = wid >> 2, tg = wid & 3;
#pragma unroll
    for (int j = 0; j < 8; ++j) { const int c = tid + 512 * j, row = c >> 4, ch = c & 15;
        *(LAS v4u*)(lds + row * SKP + ch * 16) = *(const GAS v4u*)(skl + ((size_t)h * 256 + row) * 128 + ch * 8); }
    bf16x8 qf[8];
    { const bf16* Qp = qp + (size_t)(tile * 128 + tg * 32 + r32) * QW + h * 256 + p * 128 + 8 * hi;
#pragma unroll
      for (int s = 0; s < 8; ++s) qf[s] = *(const GAS bf16x8*)(Qp + 16 * s); }
    __syncthreads();
    unsigned v[4][16];
#pragma unroll
    for (int blk = 0; blk < 4; ++blk) {
        f32x16 S = (f32x16){};
        const LAS unsigned char* kb = lds + (p * 128 + blk * 32 + r32) * SKP + hi * 16;
#pragma unroll
        for (int s = 0; s < 8; ++s) S = __builtin_amdgcn_mfma_f32_32x32x16_bf16(*(const LAS bf16x8*)(kb + s * 32), qf[s], S, 0, 0, 0);
#pragma unroll
        for (int r = 0; r < 16; ++r) v[blk][r] = (f2mono(S[r]) & ~127u) | (unsigned)(127 - (32 * blk + (r & 3) + 8 * (r >> 2)) - 4 * hi);
    }
    sort16_desc(v[0]); sort16_desc(v[1]); sort16_desc(v[2]); sort16_desc(v[3]);
    merge16_desc(v[0], v[1]); merge16_desc(v[2], v[3]); merge16_desc(v[0], v[2]);
    unsigned lo[16], up[16];
#pragma unroll
    for (int i = 0; i < 16; ++i) { auto rr = __builtin_amdgcn_permlane32_swap(v[0][i], v[0][i], false, false); lo[i] = rr[0]; up[i] = rr[1]; }
    merge16_desc(lo, up);
    LAS unsigned* cand = (LAS unsigned*)(lds + L_CAND);
    if (hi == 0) { LAS v4u* cp = (LAS v4u*)(cand + ((tg * 32 + r32) * 2 + p) * 16);
#pragma unroll
        for (int i = 0; i < 4; ++i) cp[i] = (v4u){lo[4 * i], lo[4 * i + 1], lo[4 * i + 2], lo[4 * i + 3]}; }
    __syncthreads();
    if (tid < 128) {
        const LAS unsigned* c1 = cand + (tid * 2) * 16; const LAS unsigned* c2 = c1 + 16;
        float s1[16], s2[16];
#pragma unroll
        for (int i = 0; i < 16; ++i) { s1[i] = key_score(c1[i]); s2[i] = key_score(c2[i]); }
        unsigned w[4][16];
#pragma unroll
        for (int n = 0; n < 64; ++n) w[n >> 4][n & 15] = 0u;
        { int n = 0;
#pragma unroll
          for (int i = 0; i < 16; ++i)
#pragma unroll
              for (int j = 0; j < 16; ++j) if ((i + 1) * (j + 1) <= 16) { w[n >> 4][n & 15] = (f2mono(s1[i] + s2[j]) & ~255u) | (unsigned)(255 - (i * 16 + j)); ++n; } }
        sort16_desc(w[0]); sort16_desc(w[1]); sort16_desc(w[2]); sort16_desc(w[3]);
        merge16_desc(w[0], w[1]); merge16_desc(w[2], w[3]); merge16_desc(w[0], w[2]);
        float sm[16]; int ix[16]; float mx = -1e30f;
#pragma unroll
        for (int k = 0; k < 16; ++k) { const unsigned code = 255u - (w[0][k] & 255u); const unsigned e1 = c1[code >> 4], e2 = c2[code & 15];
            sm[k] = key_score(e1) + key_score(e2); ix[k] = (int)((127u - (e1 & 127u)) * 128u + (127u - (e2 & 127u))); mx = fmaxf(mx, sm[k]); }
        float den = 0.f;
#pragma unroll
        for (int k = 0; k < 16; ++k) { sm[k] = __builtin_amdgcn_exp2f((sm[k] - mx) * LOG2E); den += sm[k]; }
        const float rden = 1.0f / den;
        const size_t o = (size_t)(tile * 128 + tid) * NSEL + h * 16;
#pragma unroll
        for (int i = 0; i < 4; ++i) { *(GAS v4u*)(idxo + o + 4 * i) = (v4u){(unsigned)ix[4 * i], (unsigned)ix[4 * i + 1], (unsigned)ix[4 * i + 2], (unsigned)ix[4 * i + 3]};
            *(GAS f32x4*)(gateo + o + 4 * i) = (f32x4){sm[4 * i] * rden, sm[4 * i + 1] * rden, sm[4 * i + 2] * rden, sm[4 * i + 3] * rden}; }
    }
    __syncthreads();
}
}

__device__ __forceinline__ void phase_score(const Args& a, int layer, LAS unsigned char* lds, int vcu, int G) {
    const bf16* qp = (const bf16*)(a.ws + WS_QP); const bf16* skl = (const bf16*)(a.ws + WS_SK) + (size_t)layer * 8 * 2 * 128 * 128;
#pragma nounroll
    for (int u = vcu * 4; u < vcu * 4 + 4; ++u) peer::score_unit(lds, qp, skl, (int*)(a.ws + WS_IDX), (float*)(a.ws + WS_GATE), u >> 3, u & 7);
    (void)G;
}

__device__ __forceinline__ float gelu_erf(float x) { return 0.5f * x * (1.0f + erff(x * 0.70710678118654752f)); }
__device__ __forceinline__ float dot2bf(unsigned a, unsigned b, float c) { return __builtin_amdgcn_fdot2_f32_bf16(__builtin_bit_cast(bf16x2_t, a), __builtin_bit_cast(bf16x2_t, b), c, false); }

__device__ __forceinline__ void phase_gather(const Args& a, int layer, int vcu, int G, int wave, int lane) {
    const float* H1 = (const float*)(a.ws + WS_H1); const int* IDX = (const int*)(a.ws + WS_IDX); const float* GATE = (const float*)(a.ws + WS_GATE);
    const bf16* EU = (const bf16*)(a.ws + WS_EU) + (size_t)layer * NEXP * DM; const bf16* EV = (const bf16*)(a.ws + WS_EV) + (size_t)layer * NEXP * DM;
    const float* g2 = a.in[14] + layer * DM; const float* b2 = a.in[15] + layer * DM;
    float* Hout = a.out; bf16* HB = (bf16*)(a.ws + WS_HB);
    const int gw = vcu * NWAVES + wave, NGW = G * NWAVES;
    for (int t = gw; t < M; t += NGW) {
        const GAS f32x4* xr = (const GAS f32x4*)(H1 + (size_t)t * DM);
        const f32x4 xa0 = xr[2 * lane], xa1 = xr[2 * lane + 1], xb0 = xr[128 + 2 * lane], xb1 = xr[128 + 2 * lane + 1];
        unsigned xb[8];
        xb[0] = cvtpk(xa0.x, xa0.y); xb[1] = cvtpk(xa0.z, xa0.w); xb[2] = cvtpk(xa1.x, xa1.y); xb[3] = cvtpk(xa1.z, xa1.w);
        xb[4] = cvtpk(xb0.x, xb0.y); xb[5] = cvtpk(xb0.z, xb0.w); xb[6] = cvtpk(xb1.x, xb1.y); xb[7] = cvtpk(xb1.z, xb1.w);
        const int idx_lo = IDX[(size_t)t * NSEL + lane], idx_hi = IDX[(size_t)t * NSEL + 64 + lane];
        const float gate_lo = GATE[(size_t)t * NSEL + lane], gate_hi = GATE[(size_t)t * NSEL + 64 + lane];
        float y[16];
#pragma unroll
        for (int i = 0; i < 16; ++i) y[i] = 0.f;
#pragma unroll 1
        for (int kb = 0; kb < 16; ++kb) {
            const int ireg = kb < 8 ? idx_lo : idx_hi; const float greg = kb < 8 ? gate_lo : gate_hi; const int l0 = 8 * (kb & 7);
            v4u u0[8], u1[8], v0[8], v1[8];
#pragma unroll
            for (int k = 0; k < 8; ++k) { const int e = __builtin_amdgcn_readlane(ireg, l0 + k);
                const GAS v4u* up = (const GAS v4u*)(EU + (size_t)e * DM); u0[k] = up[lane]; u1[k] = up[64 + lane];
                const GAS v4u* vp = (const GAS v4u*)(EV + (size_t)e * DM); v0[k] = vp[lane]; v1[k] = vp[64 + lane]; }
            float d[8];
#pragma unroll
            for (int k = 0; k < 8; ++k) { float s = dot2bf(u0[k].x, xb[0], 0.f); s = dot2bf(u0[k].y, xb[1], s); s = dot2bf(u0[k].z, xb[2], s); s = dot2bf(u0[k].w, xb[3], s);
                s = dot2bf(u1[k].x, xb[4], s); s = dot2bf(u1[k].y, xb[5], s); s = dot2bf(u1[k].z, xb[6], s); s = dot2bf(u1[k].w, xb[7], s); d[k] = s; }
            float r4[4], r2[2];
#pragma unroll
            for (int j = 0; j < 4; ++j) { auto rr = __builtin_amdgcn_permlane32_swap(__float_as_uint(d[j]), __float_as_uint(d[4 + j]), false, false); r4[j] = __uint_as_float(rr[0]) + __uint_as_float(rr[1]); }
#pragma unroll
            for (int j = 0; j < 2; ++j) { auto rr = __builtin_amdgcn_permlane16_swap(__float_as_uint(r4[j]), __float_as_uint(r4[2 + j]), false, false); r2[j] = __uint_as_float(rr[0]) + __uint_as_float(rr[1]); }
            const bool b3 = (lane >> 3) & 1;
            float tot = (b3 ? r2[1] : r2[0]) + __shfl_xor(b3 ? r2[0] : r2[1], 8);
            tot += __shfl_xor(tot, 4); tot += __shfl_xor(tot, 2); tot += __shfl_xor(tot, 1);
            const float gsel = __shfl(greg, l0 + (lane >> 3));
            const float c = gsel * gelu_erf(tot);
#pragma unroll
            for (int k = 0; k < 8; ++k) { const float ck = __uint_as_float(__builtin_amdgcn_readlane(__float_as_uint(c), 8 * k));
                y[0] += ck * bf_lo(v0[k].x); y[1] += ck * bf_hi(v0[k].x); y[2] += ck * bf_lo(v0[k].y); y[3] += ck * bf_hi(v0[k].y);
                y[4] += ck * bf_lo(v0[k].z); y[5] += ck * bf_hi(v0[k].z); y[6] += ck * bf_lo(v0[k].w); y[7] += ck * bf_hi(v0[k].w);
                y[8] += ck * bf_lo(v1[k].x); y[9] += ck * bf_hi(v1[k].x); y[10] += ck * bf_lo(v1[k].y); y[11] += ck * bf_hi(v1[k].y);
                y[12] += ck * bf_lo(v1[k].z); y[13] += ck * bf_hi(v1[k].z); y[14] += ck * bf_lo(v1[k].w); y[15] += ck * bf_hi(v1[k].w); }
        }
        float z[16];
        z[0] = ALPHA * xa0.x + y[0]; z[1] = ALPHA * xa0.y + y[1]; z[2] = ALPHA * xa0.z + y[2]; z[3] = ALPHA * xa0.w + y[3];
        z[4] = ALPHA * xa1.x + y[4]; z[5] = ALPHA * xa1.y + y[5]; z[6] = ALPHA * xa1.z + y[6]; z[7] = ALPHA * xa1.w + y[7];
        z[8] = ALPHA * xb0.x + y[8]; z[9] = ALPHA * xb0.y + y[9]; z[10] = ALPHA * xb0.z + y[10]; z[11] = ALPHA * xb0.w + y[11];
        z[12] = ALPHA * xb1.x + y[12]; z[13] = ALPHA * xb1.y + y[13]; z[14] = ALPHA * xb1.z + y[14]; z[15] = ALPHA * xb1.w + y[15];
        float s = 0.f;
#pragma unroll
        for (int i = 0; i < 16; ++i) s += z[i];
        const float mean = wave_sum(s) * (1.f / DM); float s2 = 0.f;
#pragma unroll
        for (int i = 0; i < 16; ++i) { z[i] -= mean; s2 += z[i] * z[i]; }
        const float rstd = 1.f / sqrtf(wave_sum(s2) * (1.f / DM) + LN_EPS);
        const GAS f32x4* gp = (const GAS f32x4*)g2; const GAS f32x4* bp = (const GAS f32x4*)b2;
        f32x4 o[4];
#pragma unroll
        for (int q = 0; q < 4; ++q) { const int qi = (q < 2 ? 2 * lane + q : 128 + 2 * lane + (q - 2)); const f32x4 gv = gp[qi], bv = bp[qi];
            o[q] = (f32x4){z[4 * q] * rstd * gv.x + bv.x, z[4 * q + 1] * rstd * gv.y + bv.y, z[4 * q + 2] * rstd * gv.z + bv.z, z[4 * q + 3] * rstd * gv.w + bv.w}; }
        GAS f32x4* op = (GAS f32x4*)(Hout + (size_t)t * DM);
        op[2 * lane] = o[0]; op[2 * lane + 1] = o[1]; op[128 + 2 * lane] = o[2]; op[128 + 2 * lane + 1] = o[3];
        GAS v4u* hp = (GAS v4u*)(HB + (size_t)t * DM);
        hp[lane] = (v4u){cvtpk(o[0].x, o[0].y), cvtpk(o[0].z, o[0].w), cvtpk(o[1].x, o[1].y), cvtpk(o[1].z, o[1].w)};
        hp[64 + lane] = (v4u){cvtpk(o[2].x, o[2].y), cvtpk(o[2].z, o[2].w), cvtpk(o[3].x, o[3].y), cvtpk(o[3].z, o[3].w)};
    }
}

constexpr int PH_PER_LAYER = 7, NPHASE = 1 + DEPTH * PH_PER_LAYER;
#ifndef PHMASK
#define PHMASK 0xFF
#endif
constexpr int NVCU = 256;

__global__ void __launch_bounds__(NTHR, 2) fwd_kernel(Args args) {
    extern __shared__ __attribute__((aligned(16))) unsigned char lds_raw[];
    LAS unsigned char* lds = (LAS unsigned char*)lds_raw;
    const int tid = threadIdx.x, lane = tid & 63, wave = __builtin_amdgcn_readfirstlane(tid >> 6);
    const int G = gridDim.x; const int bx = blockIdx.x; const int vcu = (G % 8 == 0) ? (bx % 8) * (G / 8) + bx / 8 : bx;
    unsigned char* ws = args.ws;
    for (int u = tid; u < (LDS_BYTES - LDSCTL_OFF) / 4; u += NTHR) ((LAS unsigned*)(lds + LDSCTL_OFF))[u] = 0u;
    __syncthreads();
#if MK_SINGLE
    XcdBarrier bar = xcd_barrier_post((unsigned*)(ws + WS_CTL) + CW_BAR, (volatile LAS unsigned*)(lds + MISC_OFF) + 8);
#endif
    const int lo = args.ph_lo, hi = args.ph_hi;
#define IN(k) (lo <= (k) && (k) < hi)
#if MK_SINGLE
#define SEAM(k) do { if (IN(k) && IN((k) + 1)) { if ((k) == 0) cg::this_grid().sync(); else xcd_barrier(bar); } } while (0)
#else
#define SEAM(k) do { } while (0)
#endif
    if (IN(0)) { if (PHMASK & 128) phase_prologue(args, lds, vcu, G, wave, lane); }
    SEAM(0);
#pragma nounroll
    for (int layer = 0; layer < DEPTH; ++layer) {
        const int p0 = 1 + layer * PH_PER_LAYER;
        if (IN(p0) && (PHMASK & 1)) {
            pg8::Gemm g{(const pg8::bf16_t*)(ws + WS_HB), (const pg8::bf16_t*)(ws + WS_WIN) + (size_t)layer * INW * DM, M, INW, DM};
            pg8::StaticOrder S; S.init(M, INW, G, bx);
            pg8::EpiProj E{(pg8::bf16_t*)(ws + WS_PROJ), QSCALE};
            pg8::gemm_phase<pg8::EpiProj, pg8::StaticOrder, true, true>(lds, g, S, E);
        }
        SEAM(p0);
        if (IN(p0 + 1) && (PHMASK & 2)) {
            for (int v = vcu; v < NVCU; v += G) phase_attention(args, layer, lds, v, lane);
        }
        SEAM(p0 + 1);
        if (IN(p0 + 2) && (PHMASK & 4)) {
            const float* hres = (layer == 0) ? args.in[0] : args.out;
            pg8::Gemm g{(const pg8::bf16_t*)(ws + WS_MIX), (const pg8::bf16_t*)(ws + WS_WO) + (size_t)layer * DM * DM, M, DM, DM};
            pg8::StaticOrder S; S.init(M, DM, G, bx);
            pg8::EpiResid E{hres, (float*)(ws + WS_Z), ALPHA};
            pg8::gemm_phase<pg8::EpiResid, pg8::StaticOrder, true, true>(lds, g, S, E);
        }
        SEAM(p0 + 2);
        if (IN(p0 + 3) && (PHMASK & 8)) {
            phase_ln1((const float*)(ws + WS_Z), args.in[8] + layer * DM, args.in[9] + layer * DM, (float*)(ws + WS_H1), (bf16*)(ws + WS_H1B), vcu, G, wave, lane);
        }
        SEAM(p0 + 3);
        if (IN(p0 + 4) && (PHMASK & 16)) {
            pg8::Gemm g{(const pg8::bf16_t*)(ws + WS_H1B), (const pg8::bf16_t*)(ws + WS_WQ) + (size_t)layer * QW * DM, M, QW, DM};
            pg8::StaticOrder S; S.init(M, QW, G, bx);
            pg8::EpiBf16<0> E{(pg8::bf16_t*)(ws + WS_QP), QW, nullptr, 0, 0, 1.f};
            pg8::gemm_phase<pg8::EpiBf16<0>, pg8::StaticOrder, true, true>(lds, g, S, E);
        }
        SEAM(p0 + 4);
        if (IN(p0 + 5) && (PHMASK & 32)) {
            for (int v = vcu; v < NVCU; v += G) phase_score(args, layer, lds, v, G);
        }
        SEAM(p0 + 5);
        if (IN(p0 + 6) && (PHMASK & 64)) {
            phase_gather(args, layer, vcu, G, wave, lane);
        }
        SEAM(p0 + 6);
    }
#undef IN
#undef SEAM
}

extern "C" void kernel_launch(void* const* d_in, const int* in_sizes, int n_in, void* d_out, int out_size, void* d_ws, size_t ws_size, hipStream_t stream) {
    static int grid = 0;
    if (grid == 0) {
        if (n_in != 16 || in_sizes[0] != M * DM || out_size != M * DM || ws_size < WS_END) { fprintf(stderr, "kernel_launch: unexpected shapes (n_in %d, in0 %d, out %d, ws %zu)\n", n_in, n_in > 0 ? in_sizes[0] : -1, out_size, ws_size); grid = -1; return; }
        int dev = 0, cus = 0, per_cu = 0;
        if (hipGetDevice(&dev) != hipSuccess || hipDeviceGetAttribute(&cus, hipDeviceAttributeMultiprocessorCount, dev) != hipSuccess) { grid = -1; return; }
        if (hipFuncSetAttribute((const void*)fwd_kernel, hipFuncAttributeMaxDynamicSharedMemorySize, LDS_BYTES) != hipSuccess) { fprintf(stderr, "kernel_launch: hipFuncSetAttribute failed\n"); grid = -1; return; }
        if (hipOccupancyMaxActiveBlocksPerMultiprocessor(&per_cu, (const void*)fwd_kernel, NTHR, LDS_BYTES) != hipSuccess || per_cu < 1) { fprintf(stderr, "kernel_launch: occupancy query says %d blocks per CU\n", per_cu); (void)hipGetLastError(); grid = -1; return; }
        grid = cus;
        if (grid > NVCU) grid = NVCU;
    }
    if (grid < 0) return;
    (void)hipMemsetAsync((char*)d_ws + WS_CTL, 0, CTL_ZERO_BYTES, stream);
    Args a{};
    for (int i = 0; i < 16; ++i) a.in[i] = (const float*)d_in[i];
    a.out = (float*)d_out; a.ws = (unsigned char*)d_ws;
#if MK_SINGLE
    a.ph_lo = 0; a.ph_hi = NPHASE;
    void* params[] = {&a};
    hipError_t e = hipLaunchCooperativeKernel((const void*)fwd_kernel, dim3(grid), dim3(NTHR), params, LDS_BYTES, stream);
    if (e != hipSuccess) fprintf(stderr, "kernel_launch: cooperative launch failed: %s (grid %d)\n", hipGetErrorString(e), grid);
#else
    for (int ph = 0; ph < NPHASE; ++ph) { a.ph_lo = ph; a.ph_hi = ph + 1; hipLaunchKernelGGL(fwd_kernel, dim3(grid), dim3(NTHR), LDS_BYTES, stream, a); }
#endif
}
```

```cpp
#include <hip/hip_runtime.h>
#include <hip/hip_cooperative_groups.h>
#include <cstdio>
#include <cstdint>
#ifndef MK_SINGLE
#define MK_SINGLE 1
#endif
__device__ __forceinline__ int opaque_tid() { int t = threadIdx.x; asm volatile("" : "+v"(t)); return t; }
namespace pg8 {
#define PG8_LAS __attribute__((address_space(3)))
typedef unsigned short bf16_t;
typedef short bf16x8 __attribute__((ext_vector_type(8)));
typedef float f32x4 __attribute__((ext_vector_type(4)));
typedef unsigned u32x4 __attribute__((ext_vector_type(4)));
constexpr int BM = 256, BK = 64, HALF = 128, HTB = HALF * BK * 2  , STAGE_BYTES = 8 * HTB, NXCD = 8, WGM = 8;

__host__ __device__ __forceinline__ int lds_byte(int r, int c) { const int st = (r >> 4) * 2 + (c >> 5), rr = r & 15, cc = c & 31, ob = rr * 64 + cc * 2; return st * 1024 + (ob ^ (((ob >> 9) & 1) << 5)); }
__host__ __device__ __forceinline__ void stage_rc(int b, int& R, int& C) { const int st = b / 1024, sb = b % 1024, swz = sb ^ (((sb >> 9) & 1) << 5); R = (st >> 1) * 16 + swz / 64; C = (st & 1) * 32 + (swz % 64) / 2; }
__host__ __device__ __forceinline__ int perm32(int rho) { const int n = rho >> 4, i = rho & 15; return 8 * (i >> 2) + 4 * n + (i & 3); }

struct Unit { int pm, pn; };
struct Gemm { const bf16_t* A; const bf16_t* Bt; int M, N, K; };

struct StaticOrder {
    int nM, nN, nwg, G, c;
    __host__ __device__ void init(int M, int N, int G_, int c_) { nM = M / BM; nN = N / BM; nwg = nM * nN; G = G_; c = c_; }
    __host__ __device__ bool next(int i, Unit& u) const {
        const long L = (long)i * G + c; if (L >= nwg) return false;
        int wgid = (int)L; { const int q = nwg / NXCD, r = nwg % NXCD, xcd = wgid % NXCD, off = wgid / NXCD; wgid = (xcd < r ? xcd * (q + 1) : r * (q + 1) + (xcd - r) * q) + off; }
        const int nig = WGM * nN, gid = wgid / nig, fm = gid * WGM, gsz = (nM - fm) < WGM ? (nM - fm) : WGM;
        u.pm = fm + ((wgid % nig) % gsz); u.pn = (wgid % nig) / gsz; return true;
    }
    __device__ __forceinline__ void a_ready(const Unit&) const {}
    __device__ __forceinline__ void done(const Unit&) const {}
};

__device__ __forceinline__ unsigned cvt_pk_bf16(float lo, float hi) { unsigned r; asm volatile("v_cvt_pk_bf16_f32 %0, %1, %2" : "=v"(r) : "v"(lo), "v"(hi)); return r; }
typedef float f32x2 __attribute__((ext_vector_type(2)));
__device__ __forceinline__ f32x2 gelu_pk(f32x2 v) {
    const f32x2 av = __builtin_elementwise_abs(v), d = av * 0.2316418882f + 1.0f;
    f32x2 t; t.x = __builtin_amdgcn_rcpf(d.x); t.y = __builtin_amdgcn_rcpf(d.y);
    f32x2 q = t * 0.5307027145f + (-0.7265760135f); q = q * t + 0.7107068705f; q = q * t + (-0.142248368f); q = q * t + 0.127414796f; q = q * t;
    const f32x2 s = (v * v) * (-0.72134752044f);
    f32x2 e; e.x = __builtin_amdgcn_exp2f(s.x); e.y = __builtin_amdgcn_exp2f(s.y);
    const f32x2 m = v * (q * e), r = v - m;
    f32x2 o; o.x = v.x < 0.f ? m.x : r.x; o.y = v.y < 0.f ? m.y : r.y; return o;
}

template <int ACT  > struct EpiBf16 {
    static constexpr bool PERM = true, AFTER_DRAIN = false; static_assert(ACT == 0 || ACT == 1, "EpiBf16: ACT is 0 (none) or 1 (gelu_pk)");
    bf16_t* O; int ldc; const float* bias; int split_cols; size_t split_stride; float scale0;
    __device__ __forceinline__ void operator()(const f32x4 (&acc)[2][2][4][2], const Unit& u, int wr, int wc, int fr, int fq) const {
        const int row0 = u.pm * BM + wr * 64 + fr; int colt = u.pn * BM; bf16_t* base = O;
        float sc = 1.f; if (split_cols) { const int t = colt / split_cols; base += (size_t)t * split_stride; colt -= t * split_cols; if (t == 0) sc = scale0; }
        const int col0 = colt + wc * 32 + 8 * fq, bcol0 = u.pn * BM + wc * 32 + 8 * fq;
        f32x4 bv[2][2];
#pragma unroll
        for (int bj = 0; bj < 2; ++bj)
#pragma unroll
            for (int n = 0; n < 2; ++n) bv[bj][n] = bias ? *(const f32x4*)(bias + bcol0 + bj * HALF + 4 * n) : (f32x4){0.f, 0.f, 0.f, 0.f};
#pragma unroll
        for (int ai = 0; ai < 2; ++ai)
#pragma unroll
            for (int m = 0; m < 4; ++m) { bf16_t* rowp = base + (size_t)(row0 + ai * HALF + m * 16) * ldc + col0;
#pragma unroll
                for (int bj = 0; bj < 2; ++bj) { f32x4 v0 = acc[ai][bj][m][0] + bv[bj][0], v1 = acc[ai][bj][m][1] + bv[bj][1];
                    if (ACT == 1) { f32x2 a = gelu_pk((f32x2){v0[0], v0[1]}), b = gelu_pk((f32x2){v0[2], v0[3]}), c = gelu_pk((f32x2){v1[0], v1[1]}), d = gelu_pk((f32x2){v1[2], v1[3]});
                        v0 = (f32x4){a.x, a.y, b.x, b.y}; v1 = (f32x4){c.x, c.y, d.x, d.y}; }
                    v0 = v0 * sc; v1 = v1 * sc; u32x4 w; w.x = cvt_pk_bf16(v0[0], v0[1]); w.y = cvt_pk_bf16(v0[2], v0[3]); w.z = cvt_pk_bf16(v1[0], v1[1]); w.w = cvt_pk_bf16(v1[2], v1[3]);
                    *(u32x4*)(rowp + bj * HALF) = w; } }
    }
};

struct PanelStats {
    unsigned* xbuf;
    unsigned* cnt;
    unsigned* tmo;
    int ntn; float eps;
    unsigned code;
    __device__ __forceinline__ bool run(const f32x4 (&v)[2][2][4][2], const Unit& u, int wr, int wc, int fr, int fq, PG8_LAS unsigned char* lds, int wid, int lane) const {
        typedef float f32x2v __attribute__((ext_vector_type(2)));
        PG8_LAS f32x2v* P = (PG8_LAS f32x2v*)lds;
        PG8_LAS f32x2v* S = (PG8_LAS f32x2v*)(lds + 8192);
        PG8_LAS unsigned* flag = (PG8_LAS unsigned*)(lds + 8192 + 2048);
#pragma unroll
        for (int ai = 0; ai < 2; ++ai)
#pragma unroll
            for (int m = 0; m < 4; ++m) {
                float s = 0.f;
#pragma unroll
                for (int bj = 0; bj < 2; ++bj)
#pragma unroll
                    for (int n = 0; n < 2; ++n) { const f32x4 x = v[ai][bj][m][n]; s += (x[0] + x[1]) + (x[2] + x[3]); }
                s += __shfl_xor(s, 16); s += __shfl_xor(s, 32);
                const float mw = s * (1.0f / 64.0f); float q = 0.f;
#pragma unroll
                for (int bj = 0; bj < 2; ++bj)
#pragma unroll
                    for (int n = 0; n < 2; ++n) { const f32x4 d = v[ai][bj][m][n] - mw; q += (d[0] * d[0] + d[1] * d[1]) + (d[2] * d[2] + d[3] * d[3]); }
                q += __shfl_xor(q, 16); q += __shfl_xor(q, 32);
                if (fq == 0) P[(ai * HALF + wr * 64 + m * 16 + fr) * 4 + wc] = (f32x2v){mw, q};
            }
        asm volatile("s_waitcnt lgkmcnt(0)" ::: "memory"); __builtin_amdgcn_s_barrier(); asm volatile("" ::: "memory");
#if defined(BROKEN_EXCHANGE_NO_WAIT)
#warning BROKEN CONTROL BUILD: the row-statistics exchange does not wait; results are wrong by design
        if (blockIdx.x >= 64) { const long long t0_ = clock64(); while (clock64() - t0_ < 60000) __builtin_amdgcn_s_sleep(8); }
#endif
        const int row = wid * 32 + (lane & 31);
        if (lane < 32) {
            const f32x2v a = P[row * 4 + 0], b = P[row * 4 + 1], c = P[row * 4 + 2], d = P[row * 4 + 3];
            const float mt = (a.x + b.x + c.x + d.x) * 0.25f;
            const float da = a.x - mt, db = b.x - mt, dc = c.x - mt, dd = d.x - mt;
            const float m2 = (a.y + b.y) + (c.y + d.y) + 64.0f * ((da * da + db * db) + (dc * dc + dd * dd));
            unsigned long long* slot = (unsigned long long*)xbuf + ((size_t)(u.pm * BM + row) * 4 + u.pn);
            __hip_atomic_store(slot, ((unsigned long long)__float_as_uint(m2) << 32) | __float_as_uint(mt), __ATOMIC_RELAXED, __HIP_MEMORY_SCOPE_AGENT);
        }
        asm volatile("s_waitcnt vmcnt(0)" ::: "memory");
        if (lane == 0) __hip_atomic_fetch_add(cnt + 64 * u.pm, 1u, __ATOMIC_RELAXED, __HIP_MEMORY_SCOPE_AGENT);
        if (wid == 0) {
            bool dead = false; const unsigned long long t0 = __builtin_amdgcn_s_memrealtime(); const unsigned want = 8u * (unsigned)ntn;
            for (;;) {
#if defined(BROKEN_EXCHANGE_NO_WAIT)
                break;
#endif
                if ((unsigned)__builtin_amdgcn_readfirstlane(__hip_atomic_load(cnt + 64 * u.pm, __ATOMIC_RELAXED, __HIP_MEMORY_SCOPE_AGENT)) >= want) break;
                if (__builtin_amdgcn_s_memrealtime() - t0 > 2000000ull) {
                    if (lane == 0) { unsigned expect = 0u; __hip_atomic_compare_exchange_strong(tmo + 1, &expect, code | (unsigned)(u.pm & 0xff), __ATOMIC_RELAXED, __ATOMIC_RELAXED, __HIP_MEMORY_SCOPE_AGENT);
                                     __hip_atomic_store(tmo, 1u, __ATOMIC_RELAXED, __HIP_MEMORY_SCOPE_AGENT); }
                    dead = true; break; }
                __builtin_amdgcn_s_sleep(2);
            }
            __builtin_amdgcn_fence(__ATOMIC_ACQUIRE, "agent");
            if (lane == 0) flag[0] = dead ? 1u : 0u;
        }
        asm volatile("s_waitcnt vmcnt(0) lgkmcnt(0)" ::: "memory"); __builtin_amdgcn_s_barrier(); asm volatile("" ::: "memory");
        const bool bad = flag[0] != 0u;
        if (lane < 32) {
            const unsigned long long* slot = (const unsigned long long*)xbuf + (size_t)(u.pm * BM + row) * 4; float mt[4], m2[4]; float ms = 0.f;
#pragma unroll
            for (int t = 0; t < 4; ++t) { if (t < ntn) { const unsigned long long w = __hip_atomic_load(slot + t, __ATOMIC_RELAXED, __HIP_MEMORY_SCOPE_AGENT); mt[t] = __uint_as_float((unsigned)w); m2[t] = __uint_as_float((unsigned)(w >> 32)); } else { mt[t] = 0.f; m2[t] = 0.f; } ms += mt[t]; }
            const float mean = ms / (float)ntn; float q = 0.f;
#pragma unroll
            for (int t = 0; t < 4; ++t) if (t < ntn) { const float dm = mt[t] - mean; q += m2[t] + 256.0f * dm * dm; }
            S[row] = (f32x2v){mean, 1.0f / sqrtf(q / (256.0f * (float)ntn) + eps)};
        }
        asm volatile("s_waitcnt lgkmcnt(0)" ::: "memory"); __builtin_amdgcn_s_barrier(); asm volatile("" ::: "memory");
        return bad;
    }
};
struct EpiLnRes {
    static constexpr bool PERM = false, AFTER_DRAIN = true;
    const float* base; float* out; int ldc; const float* bias; PanelStats st; unsigned poison;
    __device__ __forceinline__ void fused(f32x4 (&acc)[2][2][4][2], const Unit& u, int wr, int wc, int fr, int fq, PG8_LAS unsigned char* lds, int wid, int lane) const {
        typedef float f32x2v __attribute__((ext_vector_type(2)));
        const PG8_LAS f32x2v* S = (const PG8_LAS f32x2v*)(lds + 8192);
        const int col0 = u.pn * BM + wc * 32 + 4 * fq;
#pragma unroll
        for (int bj = 0; bj < 2; ++bj)
#pragma unroll
            for (int n = 0; n < 2; ++n) { const f32x4 bv = bias ? *(const f32x4*)(bias + col0 + bj * HALF + n * 16) : (f32x4){0.f, 0.f, 0.f, 0.f};
#pragma unroll
                for (int ai = 0; ai < 2; ++ai)
#pragma unroll
                    for (int m = 0; m < 4; ++m) acc[ai][bj][m][n] += bv; }
        f32x4 pre[4][2][2];
#pragma unroll
        for (int m = 0; m < 4; ++m) { const size_t off = (size_t)(u.pm * BM + wr * 64 + m * 16 + fr) * ldc + col0;
#pragma unroll
            for (int bj = 0; bj < 2; ++bj)
#pragma unroll
                for (int n = 0; n < 2; ++n) pre[m][bj][n] = *(const f32x4*)(base + off + bj * HALF + n * 16); }
        const bool bad = st.run(acc, u, wr, wc, fr, fq, lds, wid, lane) || poison != 0u;
        const float qnan = __builtin_nanf("");
#pragma unroll
        for (int ai = 0; ai < 2; ++ai)
#pragma unroll
            for (int m = 0; m < 4; ++m) { const int r = ai * HALF + wr * 64 + m * 16 + fr; const f32x2v sr = S[r]; const size_t off = (size_t)(u.pm * BM + r) * ldc + col0;
#pragma unroll
                for (int bj = 0; bj < 2; ++bj)
#pragma unroll
                    for (int n = 0; n < 2; ++n) { const f32x4 bs = ai == 0 ? pre[m][bj][n] : *(const f32x4*)(base + off + bj * HALF + n * 16); f32x4 o = bs + (acc[ai][bj][m][n] - sr.x) * sr.y;
                        if (bad) o = (f32x4){qnan, qnan, qnan, qnan}; *(f32x4*)(out + off + bj * HALF + n * 16) = o; }
                if (m & 1) asm volatile("" ::: "memory"); }
    }
};
struct EpiLnResLn {
    static constexpr bool PERM = false, AFTER_DRAIN = true;
    const float* base; float* out; bf16_t* xn; int ldc; const float* bias; PanelStats st1, st2; unsigned poison;
    __device__ __forceinline__ void fused(f32x4 (&acc)[2][2][4][2], const Unit& u, int wr, int wc, int fr, int fq, PG8_LAS unsigned char* lds, int wid, int lane) const {
        typedef float f32x2v __attribute__((ext_vector_type(2))); typedef unsigned u32x2v __attribute__((ext_vector_type(2)));
        const PG8_LAS f32x2v* S = (const PG8_LAS f32x2v*)(lds + 8192);
        const int col0 = u.pn * BM + wc * 32 + 4 * fq;
#pragma unroll
        for (int bj = 0; bj < 2; ++bj)
#pragma unroll
            for (int n = 0; n < 2; ++n) { const f32x4 bv = bias ? *(const f32x4*)(bias + col0 + bj * HALF + n * 16) : (f32x4){0.f, 0.f, 0.f, 0.f};
#pragma unroll
                for (int ai = 0; ai < 2; ++ai)
#pragma unroll
                    for (int m = 0; m < 4; ++m) acc[ai][bj][m][n] += bv; }
        bool bad = st1.run(acc, u, wr, wc, fr, fq, lds, wid, lane) || poison != 0u;
        const float qnan = __builtin_nanf("");
#pragma unroll
        for (int ai = 0; ai < 2; ++ai)
#pragma unroll
            for (int m = 0; m < 4; ++m) { const int r = ai * HALF + wr * 64 + m * 16 + fr; const f32x2v sr = S[r]; const size_t off = (size_t)(u.pm * BM + r) * ldc + col0;
#pragma unroll
                for (int bj = 0; bj < 2; ++bj)
#pragma unroll
                    for (int n = 0; n < 2; ++n) { const f32x4 bs = *(const f32x4*)(base + off + bj * HALF + n * 16); acc[ai][bj][m][n] = bs + (acc[ai][bj][m][n] - sr.x) * sr.y; }
                asm volatile("" : "+v"(acc[ai][0][m][0]), "+v"(acc[ai][0][m][1]), "+v"(acc[ai][1][m][0]), "+v"(acc[ai][1][m][1]));
                if (m & 1) asm volatile("" ::: "memory"); }
        const bool bad1 = bad;
        bad = st2.run(acc, u, wr, wc, fr, fq, lds, wid, lane) || bad;
#pragma unroll
        for (int ai = 0; ai < 2; ++ai)
#pragma unroll
            for (int m = 0; m < 4; ++m) { const int r = ai * HALF + wr * 64 + m * 16 + fr; const f32x2v sr = S[r]; const size_t off = (size_t)(u.pm * BM + r) * ldc + col0;
#pragma unroll
                for (int bj = 0; bj < 2; ++bj)
#pragma unroll
                    for (int n = 0; n < 2; ++n) { const f32x4 x1 = acc[ai][bj][m][n]; *(f32x4*)(out + off + bj * HALF + n * 16) = bad1 ? (f32x4){qnan, qnan, qnan, qnan} : x1;
                        const f32x4 o = (x1 - sr.x) * sr.y; u32x2v w; w.x = cvt_pk_bf16(o[0], o[1]); w.y = cvt_pk_bf16(o[2], o[3]);
                        if (bad) { w.x = 0x7fc07fc0u; w.y = 0x7fc07fc0u; } *(u32x2v*)(xn + off + bj * HALF + n * 16) = w; }
                asm volatile("" ::: "memory"); }
    }
};

template <class Epi, class Sched, bool ALIGN_EPI = false, bool SP2 = false>
__device__ __forceinline__ void gemm_phase(PG8_LAS unsigned char* lds, const Gemm g, const Sched& S, const Epi& E) {
    const int tid = opaque_tid(), wid = __builtin_amdgcn_readfirstlane(tid >> 6), lane = tid & 63, wr = wid >> 2, wc = wid & 3, fr = lane & 15, fq = lane >> 4;
    const int K = g.K, nt = K / BK;
    unsigned voffA[2], voffB[2];
#pragma unroll
    for (int i = 0; i < 2; ++i) { int R, C; stage_rc(tid * 16 + i * 8192, R, C); const int Rb = Epi::PERM ? ((R & ~31) + perm32(R & 31)) : R;
        voffA[i] = (unsigned)(R * K + C) * 2u; voffB[i] = (unsigned)(Rb * K + C) * 2u; }
    const size_t kstep = (size_t)(BK * 2);
    const size_t hstep = (size_t)HALF * K * 2;
    const size_t tstep = 2 * hstep;
    const unsigned ldsw = (unsigned)wid * 1024u;
    const int aoff = lds_byte(wr * 64 + fr, fq * 8), boff = lds_byte(wc * 32 + fr, fq * 8);
#define PG8_SA(b, h) (((b) * 2 + (h)) * HTB)
#define PG8_SB(b, h) ((4 + (b) * 2 + (h)) * HTB)
#define PG8_STAGE(bufoff, gbase, voff) do { _Pragma("unroll") for (int _i = 0; _i < 2; ++_i) \
        __builtin_amdgcn_global_load_lds((const unsigned*)((const char*)(gbase) + (voff)[_i]), (PG8_LAS unsigned*)(lds + (bufoff) + ldsw + _i * 8192), 16, 0, 0); } while (0)
#define PG8_LDA(dst, b, h) do { _Pragma("unroll") for (int m = 0; m < 4; ++m) _Pragma("unroll") for (int k = 0; k < 2; ++k) dst[m][k] = *(const PG8_LAS bf16x8*)(lds + PG8_SA(b, h) + aoff + m * 2048 + k * 1024); } while (0)
#define PG8_LDB(dst, b, h) do { _Pragma("unroll") for (int n = 0; n < 2; ++n) _Pragma("unroll") for (int k = 0; k < 2; ++k) dst[n][k] = *(const PG8_LAS bf16x8*)(lds + PG8_SB(b, h) + boff + n * 2048 + k * 1024); } while (0)
#define PG8_MMA(ai, bj, At, Bt) do { __builtin_amdgcn_s_setprio(1); _Pragma("unroll") for (int m = 0; m < 4; ++m) _Pragma("unroll") for (int n = 0; n < 2; ++n) _Pragma("unroll") for (int k = 0; k < 2; ++k) \
        acc[ai][bj][m][n] = __builtin_amdgcn_mfma_f32_16x16x32_bf16(Bt[n][k], At[m][k], acc[ai][bj][m][n], 0, 0, 0); __builtin_amdgcn_s_setprio(0); } while (0)
#define PG8_WAIT_V(n) asm volatile("s_waitcnt vmcnt(" #n ")" ::: "memory")
#define PG8_WAIT_L(n) asm volatile("s_waitcnt lgkmcnt(" #n ")" ::: "memory")
#define PG8_BAR __builtin_amdgcn_s_barrier()
#define PG8_SCHED __builtin_amdgcn_sched_barrier(0)
    Unit cur, nxt; int ui = 0;
    if (!S.next(0, cur)) return;
    f32x4 acc[2][2][4][2];
#pragma unroll
    for (int a = 0; a < 2; ++a)
#pragma unroll
        for (int b = 0; b < 2; ++b)
#pragma unroll
            for (int m = 0; m < 4; ++m)
#pragma unroll
                for (int n = 0; n < 2; ++n) acc[a][b][m][n] = (f32x4){0.f, 0.f, 0.f, 0.f};
    bf16x8 At[4][2], B0[2][2], B1[2][2];
    const char* cA = (const char*)g.A + (size_t)cur.pm * tstep; const char* cB = (const char*)g.Bt + (size_t)cur.pn * tstep;
    S.a_ready(cur);
    if constexpr (SP2) {
        PG8_STAGE(PG8_SB(0, 0), cB, voffB); PG8_STAGE(PG8_SB(0, 1), cB + hstep, voffB); PG8_STAGE(PG8_SA(0, 0), cA, voffA); PG8_STAGE(PG8_SA(0, 1), cA + hstep, voffA);
        if (wr == 1) PG8_BAR;
        PG8_WAIT_V(2); PG8_BAR;
        PG8_STAGE(PG8_SB(1, 0), cB + kstep, voffB); PG8_STAGE(PG8_SA(1, 0), cA + kstep, voffA); PG8_STAGE(PG8_SB(1, 1), cB + hstep + kstep, voffB);
        PG8_WAIT_V(6); PG8_BAR;
    } else {
        PG8_STAGE(PG8_SB(0, 0), cB, voffB); PG8_STAGE(PG8_SA(0, 0), cA, voffA); PG8_STAGE(PG8_SB(0, 1), cB + hstep, voffB); PG8_STAGE(PG8_SA(0, 1), cA + hstep, voffA);
        if (wr == 1) PG8_BAR;
        PG8_WAIT_V(4); PG8_BAR;
        PG8_STAGE(PG8_SB(1, 0), cB + kstep, voffB); PG8_STAGE(PG8_SA(1, 0), cA + kstep, voffA); PG8_STAGE(PG8_SB(1, 1), cB + hstep + kstep, voffB);
        PG8_WAIT_V(6); PG8_BAR;
    }
    for (;;) {
        const bool has_next = S.next(ui + 1, nxt);
        const char* nA = has_next ? (const char*)g.A + (size_t)nxt.pm * tstep : cA; const char* nB = has_next ? (const char*)g.Bt + (size_t)nxt.pn * tstep : cB;
        for (int t = 0; t < nt; t += 2) {
            const bool last = (t == nt - 2);
            const char* a1 = cA + (size_t)(t + 1) * kstep;
            const char* a2 = last ? nA : cA + (size_t)(t + 2) * kstep; const char* b2 = last ? nB : cB + (size_t)(t + 2) * kstep;
            const char* a3 = a2 + kstep; const char* b3 = b2 + kstep;
            if (last && has_next) S.a_ready(nxt);
            if constexpr (SP2) {
            PG8_LDB(B0, 0, 0); PG8_LDB(B1, 0, 1); PG8_SCHED; PG8_LDA(At, 0, 0); PG8_STAGE(PG8_SA(1, 1), a1 + hstep, voffA);
            PG8_WAIT_V(8); PG8_WAIT_L(0); PG8_BAR; PG8_MMA(0, 0, At, B0); PG8_MMA(0, 1, At, B1); PG8_BAR; PG8_SCHED;
            PG8_LDA(At, 0, 1); PG8_STAGE(PG8_SB(0, 0), b2, voffB); PG8_STAGE(PG8_SB(0, 1), b2 + hstep, voffB); PG8_STAGE(PG8_SA(0, 0), a2, voffA);
            PG8_WAIT_V(8); PG8_WAIT_L(0); PG8_BAR; PG8_MMA(1, 0, At, B0); PG8_MMA(1, 1, At, B1); PG8_BAR; PG8_SCHED;
            PG8_LDB(B0, 1, 0); PG8_LDB(B1, 1, 1); PG8_SCHED; PG8_LDA(At, 1, 0); PG8_STAGE(PG8_SA(0, 1), a2 + hstep, voffA);
            PG8_WAIT_V(8); PG8_WAIT_L(0); PG8_BAR; PG8_MMA(0, 0, At, B0); PG8_MMA(0, 1, At, B1); PG8_BAR; PG8_SCHED;
            PG8_LDA(At, 1, 1); PG8_STAGE(PG8_SB(1, 0), b3, voffB); PG8_STAGE(PG8_SB(1, 1), b3 + hstep, voffB); PG8_STAGE(PG8_SA(1, 0), a3, voffA);
            PG8_WAIT_V(8); PG8_WAIT_L(0); PG8_BAR; PG8_MMA(1, 0, At, B0); PG8_MMA(1, 1, At, B1); PG8_BAR; PG8_SCHED;
            } else {
            PG8_LDB(B0, 0, 0); PG8_SCHED; PG8_LDA(At, 0, 0); PG8_STAGE(PG8_SA(1, 1), a1 + hstep, voffA);
            PG8_WAIT_L(8); PG8_BAR; PG8_WAIT_L(0); PG8_MMA(0, 0, At, B0); PG8_BAR; PG8_SCHED;
            PG8_LDB(B1, 0, 1); PG8_STAGE(PG8_SB(0, 0), b2, voffB);
            PG8_BAR; PG8_WAIT_L(0); PG8_MMA(0, 1, At, B1); PG8_BAR;
            PG8_LDA(At, 0, 1); PG8_STAGE(PG8_SA(0, 0), a2, voffA);
            PG8_BAR; PG8_WAIT_L(0); PG8_MMA(1, 0, At, B0); PG8_BAR; PG8_SCHED;
            PG8_STAGE(PG8_SB(0, 1), b2 + hstep, voffB);
            PG8_WAIT_V(6); PG8_BAR; PG8_MMA(1, 1, At, B1); PG8_BAR;
            PG8_LDB(B0, 1, 0); PG8_SCHED; PG8_LDA(At, 1, 0); PG8_STAGE(PG8_SA(0, 1), a2 + hstep, voffA);
            PG8_WAIT_L(8); PG8_BAR; PG8_WAIT_L(0); PG8_MMA(0, 0, At, B0); PG8_BAR; PG8_SCHED;
            PG8_LDB(B1, 1, 1); PG8_STAGE(PG8_SB(1, 0), b3, voffB);
            PG8_BAR; PG8_WAIT_L(0); PG8_MMA(0, 1, At, B1); PG8_BAR;
            PG8_LDA(At, 1, 1); PG8_STAGE(PG8_SA(1, 0), a3, voffA);
            PG8_BAR; PG8_WAIT_L(0); PG8_MMA(1, 0, At, B0); PG8_BAR; PG8_SCHED;
            PG8_STAGE(PG8_SB(1, 1), b3 + hstep, voffB);
            PG8_WAIT_V(6); PG8_BAR; PG8_MMA(1, 1, At, B1); PG8_BAR;
            }
        }
        if constexpr (ALIGN_EPI) { if (wr == 0) PG8_BAR; }
        if constexpr (!Epi::AFTER_DRAIN) { E(acc, cur, wr, wc, fr, fq); S.done(cur); }
        if (!has_next) break;
#pragma unroll
        for (int a = 0; a < 2; ++a)
#pragma unroll
            for (int b = 0; b < 2; ++b)
#pragma unroll
                for (int m = 0; m < 4; ++m)
#pragma unroll
                    for (int n = 0; n < 2; ++n) acc[a][b][m][n] = (f32x4){0.f, 0.f, 0.f, 0.f};
        cur = nxt; cA = nA; cB = nB; ++ui;
        if constexpr (ALIGN_EPI) { if (wr == 1) PG8_BAR; }
    }
    PG8_WAIT_V(0);
    if constexpr (!ALIGN_EPI) { if (wr == 0) PG8_BAR; }
    PG8_BAR;
    if constexpr (Epi::AFTER_DRAIN) { E.fused(acc, cur, wr, wc, fr, fq, lds, wid, lane); S.done(cur); }
#undef PG8_SA
#undef PG8_SB
#undef PG8_STAGE
#undef PG8_LDA
#undef PG8_LDB
#undef PG8_MMA
#undef PG8_WAIT_V
#undef PG8_WAIT_L
#undef PG8_BAR
#undef PG8_SCHED
}
}
#define GAS __attribute__((address_space(1)))
#define LAS __attribute__((address_space(3)))
typedef unsigned short bf16;
typedef unsigned v4u __attribute__((ext_vector_type(4)));
typedef float f32x4 __attribute__((ext_vector_type(4)));
typedef short bf16x8 __attribute__((ext_vector_type(8)));
typedef GAS unsigned gu32;
typedef GAS unsigned long long gu64;
#define RLX_AGENT __ATOMIC_RELAXED, __HIP_MEMORY_SCOPE_AGENT
#define LDS_WAIT() asm volatile("s_waitcnt lgkmcnt(0)" ::: "memory")
#define VM_WAIT() asm volatile("s_waitcnt vmcnt(0)" ::: "memory")
__device__ __forceinline__ unsigned long long rt() { return __builtin_amdgcn_s_memrealtime(); }
__device__ __forceinline__ unsigned f2bf(float f) { unsigned u = __builtin_bit_cast(unsigned, f); return (u + 0x7fffu + ((u >> 16) & 1u)) >> 16; }
__device__ __forceinline__ unsigned pk2(float lo, float hi) { return f2bf(lo) | (f2bf(hi) << 16); }

#define XB_TMO      128
#define XB_XCNT(j)  (256  + 64 * (j))
#define XB_XSUB(j)  (1280 + 64 * (j))
#define XB_XGEN(j)  (2304 + 64 * (j))
#define XB_TOP      3328
#define XB_TOPGEN   3392
#define XCD_BAR_WORDS 3456
#define XB_SPIN_CAP (1u << 18)

__device__ __forceinline__ unsigned xb_ld(unsigned* p)              { return __hip_atomic_load(p, __ATOMIC_RELAXED, __HIP_MEMORY_SCOPE_AGENT); }
__device__ __forceinline__ unsigned xb_add(unsigned* p, unsigned v) { return __hip_atomic_fetch_add(p, v, __ATOMIC_RELAXED, __HIP_MEMORY_SCOPE_AGENT); }
__device__ __forceinline__ unsigned xb_xcc_id() { return (unsigned)__builtin_amdgcn_s_getreg((3 << 11) | 20) & 0xFu; }
#define XB_SPIN(cond, bar) do { unsigned _sp = 0; while (cond) { __builtin_amdgcn_s_sleep(1); \
    if ((++_sp & 255u) == 0u) { if (xb_ld(&(bar)[XB_TMO])) break; if (_sp > XB_SPIN_CAP) { atomicAdd(&(bar)[XB_TMO], 1u); break; } } } } while (0)

struct XcdBarrier {
    unsigned* bar; unsigned x;
    volatile LAS unsigned* st;
};

__device__ __forceinline__ XcdBarrier xcd_barrier_post(unsigned* bar, volatile LAS unsigned* st) {
    XcdBarrier b; b.bar = bar; b.x = xb_xcc_id(); b.st = st;
    if (threadIdx.x == 0) (void)xb_add(&bar[XB_XCNT(b.x)], 1u);
    return b;
}
__device__ __forceinline__ void xcd_barrier_complete(unsigned* bar, unsigned x, unsigned& nloc, unsigned& nx) {
    const unsigned G = gridDim.x * gridDim.y * gridDim.z;
    unsigned sum, cnt, mine, sp = 0u;
    for (;;) {
        sum = 0u; cnt = 0u; mine = 0u;
#pragma nounroll
        for (unsigned j = 0; j < 16; ++j) { const unsigned c = xb_ld(&bar[XB_XCNT(j)]); sum += c; cnt += (c > 0u) ? 1u : 0u; mine = (j == x) ? c : mine; }
        if (sum == G) break;
        __builtin_amdgcn_s_sleep(1);
        if ((++sp & 255u) == 0u) { if (xb_ld(&bar[XB_TMO])) break; if (sp > XB_SPIN_CAP) { atomicAdd(&bar[XB_TMO], 1u); break; } }
    }
    nloc = mine > 0u ? mine : 1u; nx = cnt > 0u ? cnt : 1u;
}

__device__ __forceinline__ void xcd_barrier(const XcdBarrier& b) {
    asm volatile("s_waitcnt vmcnt(0)" ::: "memory");
    __syncthreads();
    if (threadIdx.x == 0) {
        unsigned* bar = b.bar; asm volatile("" : "+s"(bar));
        __builtin_amdgcn_s_waitcnt(0);
        unsigned nloc = b.st[0], nx = b.st[1];
        if (nloc == 0u) { xcd_barrier_complete(bar, b.x, nloc, nx); b.st[0] = nloc; b.st[1] = nx; }
        const unsigned old = xb_add(&bar[XB_XSUB(b.x)], 1u);
        const unsigned gen = old / nloc;
        if (old + 1u == (gen + 1u) * nloc) {
            __builtin_amdgcn_fence(__ATOMIC_RELEASE, "agent");
            asm volatile("s_waitcnt vmcnt(0)" ::: "memory");
            const unsigned og = xb_add(&bar[XB_TOP], 1u);
            const unsigned tg = og / nx;
            if (og + 1u == (tg + 1u) * nx) xb_add(&bar[XB_TOPGEN], 1u);
            else XB_SPIN(xb_ld(&bar[XB_TOPGEN]) == tg, bar);
            __builtin_amdgcn_fence(__ATOMIC_ACQUIRE, "agent");
            xb_add(&bar[XB_XGEN(b.x)], 1u);
            asm volatile("s_waitcnt vmcnt(0)" ::: "memory");
        } else {
            XB_SPIN(xb_ld(&bar[XB_XGEN(b.x)]) == gen, bar);
            __builtin_amdgcn_fence(__ATOMIC_ACQUIRE, "agent");
            asm volatile("s_waitcnt vmcnt(0)" ::: "memory");
        }
    }
    __syncthreads();
}

namespace cg = cooperative_groups;
constexpr int NWAVES = 8, NTHR = 512;
constexpr int BATCH = 8, SEQ = 2048, DM = 1024, M = BATCH * SEQ, DEPTH = 4;
constexpr int INW = 3072, QW = 2048, NEXP = 16384, NSEL = 128;
constexpr float ALPHA = 1.6817928305074292f;
constexpr float LN_EPS = 1e-5f, RMS_EPS = 1e-5f;
constexpr float LOG2E = 1.4426950408889634f;
constexpr float QSCALE = 0.125f * LOG2E;
typedef float f32x16 __attribute__((ext_vector_type(16)));
typedef short s16x4 __attribute__((ext_vector_type(4)));
typedef float f32x2_t __attribute__((ext_vector_type(2)));
typedef __bf16 bf16x2_t __attribute__((ext_vector_type(2)));
typedef unsigned v2u __attribute__((ext_vector_type(2)));

constexpr size_t MiB = 1u << 20;
constexpr size_t WS_CTL = 0, CTL_ZERO_BYTES = 1 * MiB;
constexpr size_t WS_WIN = 2 * MiB;
constexpr size_t WS_WO = 26 * MiB;
constexpr size_t WS_WQ = 34 * MiB;
constexpr size_t WS_SK = 50 * MiB;
constexpr size_t WS_USC = 52 * MiB;
constexpr size_t WS_VSC = 53 * MiB;
constexpr size_t WS_EU = 64 * MiB;
constexpr size_t WS_EV = 192 * MiB;
constexpr size_t WS_HB = 320 * MiB;
constexpr size_t WS_H1B = 352 * MiB;
constexpr size_t WS_PROJ = 384 * MiB;
constexpr size_t WS_MIX = 480 * MiB;
constexpr size_t WS_Z = 512 * MiB;
constexpr size_t WS_H1 = 576 * MiB;
constexpr size_t WS_QP = 640 * MiB;
constexpr size_t WS_IDX = 704 * MiB;
constexpr size_t WS_GATE = 712 * MiB;
constexpr size_t WS_END = 720 * MiB;
constexpr int CW_BAR = 4096;

constexpr int RING_BYTES = 131072;
constexpr int LDSCTL_OFF = RING_BYTES, MISC_OFF = LDSCTL_OFF + 320;
constexpr int LDS_BYTES = 147456;

__device__ __forceinline__ unsigned cvtpk(float lo, float hi) { f32x2_t v = {lo, hi}; bf16x2_t b = __builtin_convertvector(v, bf16x2_t); return __builtin_bit_cast(unsigned, b); }
__device__ __forceinline__ float bf_lo(unsigned w) { return __builtin_bit_cast(float, w << 16); }
__device__ __forceinline__ float bf_hi(unsigned w) { return __builtin_bit_cast(float, w & 0xffff0000u); }
__device__ __forceinline__ float wave_sum(float v) {
#pragma unroll
    for (int o = 1; o < 64; o <<= 1) v += __shfl_xor(v, o);
    return v;
}
__device__ __forceinline__ int crow(int r, int hi) { return (r & 3) + 8 * (r >> 2) + 4 * hi; }

namespace pg8 {
struct EpiProj {
    static constexpr bool PERM = true, AFTER_DRAIN = false;
    bf16_t* O; float qs;
    __device__ __forceinline__ void operator()(const f32x4 (&acc)[2][2][4][2], const Unit& u, int wr, int wc, int fr, int fq) const {
        const int row0 = u.pm * BM + wr * 64 + fr, col0 = u.pn * BM + wc * 32 + 8 * fq, reg = u.pn >> 1;
        const float sc = (reg == 0 || reg == 3) ? qs : 1.0f;
#pragma unroll
        for (int ai = 0; ai < 2; ++ai)
#pragma unroll
            for (int m = 0; m < 4; ++m) { bf16_t* rowp = O + (size_t)(row0 + ai * HALF + m * 16) * 3072 + col0;
#pragma unroll
                for (int bj = 0; bj < 2; ++bj) { const f32x4 v0 = acc[ai][bj][m][0] * sc, v1 = acc[ai][bj][m][1] * sc;
                    u32x4 w; w.x = cvt_pk_bf16(v0[0], v0[1]); w.y = cvt_pk_bf16(v0[2], v0[3]); w.z = cvt_pk_bf16(v1[0], v1[1]); w.w = cvt_pk_bf16(v1[2], v1[3]);
                    *(u32x4*)(rowp + bj * HALF) = w; } }
    }
};
struct EpiResid {
    static constexpr bool PERM = false, AFTER_DRAIN = false;
    const float* base; float* out; float alpha;
    __device__ __forceinline__ void operator()(const f32x4 (&acc)[2][2][4][2], const Unit& u, int wr, int wc, int fr, int fq) const {
        const int col0 = u.pn * BM + wc * 32 + 4 * fq;
#pragma unroll
        for (int ai = 0; ai < 2; ++ai)
#pragma unroll
            for (int m = 0; m < 4; ++m) { const size_t off = (size_t)(u.pm * BM + ai * HALF + wr * 64 + m * 16 + fr) * 1024 + col0;
#pragma unroll
                for (int bj = 0; bj < 2; ++bj)
#pragma unroll
                    for (int n = 0; n < 2; ++n) { const f32x4 bs = *(const f32x4*)(base + off + bj * HALF + n * 16);
                        *(f32x4*)(out + off + bj * HALF + n * 16) = bs * alpha + acc[ai][bj][m][n]; } }
    }
};
}

__device__ __forceinline__ void p0_transpose_item(const float* W, int K, int N, bf16* WT, LAS float* scr, int item, int lane) {
    const int nblk = N / 32, kb = item / nblk, nb = item % nblk, k0 = 64 * kb, n0 = 32 * nb;
#pragma unroll 8
    for (int i = 0; i < 32; ++i) { const int kk = 2 * i + (lane >> 5); scr[kk * 33 + (lane & 31)] = W[(size_t)(k0 + kk) * N + n0 + (lane & 31)]; }
    LDS_WAIT(); asm volatile("" ::: "memory");
    const int c = lane & 7;
#pragma unroll
    for (int j = 0; j < 4; ++j) { const int n = (lane >> 3) + 8 * j; const LAS float* s = scr + (8 * c) * 33 + n;
        v4u o; o.x = cvtpk(s[0 * 33], s[1 * 33]); o.y = cvtpk(s[2 * 33], s[3 * 33]); o.z = cvtpk(s[4 * 33], s[5 * 33]); o.w = cvtpk(s[6 * 33], s[7 * 33]);
        *(GAS v4u*)(WT + (size_t)(n0 + n) * K + k0 + 8 * c) = o; }
    LDS_WAIT(); asm volatile("" ::: "memory");
}
__device__ __forceinline__ void cvt_stream(const float* src, bf16* dst, size_t n8, size_t gtid, size_t gthreads) {
    for (size_t c = gtid; c < n8; c += gthreads) {
        const f32x4 a = ((const GAS f32x4*)src)[2 * c], b = ((const GAS f32x4*)src)[2 * c + 1];
        v4u o; o.x = cvtpk(a.x, a.y); o.y = cvtpk(a.z, a.w); o.z = cvtpk(b.x, b.y); o.w = cvtpk(b.z, b.w);
        ((GAS v4u*)dst)[c] = o;
    }
}

struct Args { const float* in[16]; float* out; unsigned char* ws; int ph_lo, ph_hi, rep_mask, pad; };
typedef const __attribute__((address_space(4))) Args* ArgP;
__device__ __forceinline__ ArgP arg_ptr() { ArgP p = (ArgP)__builtin_amdgcn_kernarg_segment_ptr(); asm volatile("" : "+s"(p)); return p; }

__device__ __forceinline__ void phase_prologue(ArgP a, LAS unsigned char* lds, int vcu, int G) {
    const int tid = opaque_tid(), lane = tid & 63, wave = __builtin_amdgcn_readfirstlane(tid >> 6);
    unsigned char* ws = a->ws;
    LAS float* scr = (LAS float*)(lds + wave * 16384);
    const int gw = vcu * NWAVES + wave, NGW = G * NWAVES;
    constexpr int I_IN = (DM / 64) * (INW / 32), I_O = (DM / 64) * (DM / 32), I_Q = (DM / 64) * (QW / 32), I_L = I_IN + I_O + I_Q;
    for (int it = gw; it < DEPTH * I_L; it += NGW) {
        const int l = it / I_L; int r = it % I_L;
        if (r < I_IN) { p0_transpose_item(a->in[1] + (size_t)l * DM * INW, DM, INW, (bf16*)(ws + WS_WIN) + (size_t)l * INW * DM, scr, r, lane); continue; } r -= I_IN;
        if (r < I_O) { p0_transpose_item(a->in[7] + (size_t)l * DM * DM, DM, DM, (bf16*)(ws + WS_WO) + (size_t)l * DM * DM, scr, r, lane); continue; } r -= I_O;
        p0_transpose_item(a->in[10] + (size_t)l * DM * QW, DM, QW, (bf16*)(ws + WS_WQ) + (size_t)l * QW * DM, scr, r, lane);
    }
    const size_t gtid = (size_t)vcu * NTHR + tid, gthreads = (size_t)G * NTHR;
    cvt_stream(a->in[0], (bf16*)(ws + WS_HB), (size_t)M * DM / 8, gtid, gthreads);
    cvt_stream(a->in[11], (bf16*)(ws + WS_SK), (size_t)DEPTH * 8 * 2 * 128 * 128 / 8, gtid, gthreads);
    for (int row = gw; row < 2 * DEPTH * NEXP; row += NGW) {
        const int tbl = row >= DEPTH * NEXP, r = row - tbl * DEPTH * NEXP;
        const GAS f32x4* src = (const GAS f32x4*)((tbl ? a->in[13] : a->in[12]) + (size_t)r * DM) + lane;
        f32x4 v[4]; float am = 0.f;
#pragma unroll
        for (int j = 0; j < 4; ++j) { v[j] = src[64 * j]; am = fmaxf(am, fmaxf(fmaxf(fabsf(v[j].x), fabsf(v[j].y)), fmaxf(fabsf(v[j].z), fabsf(v[j].w)))); }
#pragma unroll
        for (int o = 1; o < 64; o <<= 1) am = fmaxf(am, __shfl_xor(am, o));
        const float sc = am > 0.f ? 6.0f / am : 1.0f, inv = am > 0.f ? am * (1.0f / 6.0f) : 1.0f;
        GAS unsigned short* dst = (GAS unsigned short*)(ws + (tbl ? WS_EV : WS_EU) + (size_t)r * (DM / 2)) + lane;
#pragma unroll
        for (int j = 0; j < 4; ++j) { unsigned p = __builtin_amdgcn_cvt_scalef32_pk_fp4_f32(0u, v[j].x * sc, v[j].y * sc, 1.0f, 0); p = __builtin_amdgcn_cvt_scalef32_pk_fp4_f32(p, v[j].z * sc, v[j].w * sc, 1.0f, 1); dst[64 * j] = (unsigned short)p; }
        if (lane == 0) ((float*)(ws + (tbl ? WS_VSC : WS_USC)))[r] = inv;
    }
}

__device__ __forceinline__ void phase_ln1(const float* Z, const float* g, const float* b, float* H1, bf16* H1B, int vcu, int G) {
    const int tid = opaque_tid(), lane = tid & 63, wave = __builtin_amdgcn_readfirstlane(tid >> 6);
    const int gw = vcu * NWAVES + wave, NGW = G * NWAVES;
    f32x4 gv[4], bv[4];
#pragma unroll
    for (int j = 0; j < 4; ++j) { gv[j] = ((const GAS f32x4*)g)[lane + 64 * j]; bv[j] = ((const GAS f32x4*)b)[lane + 64 * j]; }
    for (int m = gw; m < M; m += NGW) {
        const GAS f32x4* xr = (const GAS f32x4*)(Z + (size_t)m * DM) + lane;
        f32x4 v[4]; float s = 0.f;
#pragma unroll
        for (int j = 0; j < 4; ++j) { v[j] = xr[64 * j]; s += (v[j].x + v[j].y) + (v[j].z + v[j].w); }
        const float mean = wave_sum(s) * (1.f / DM); float s2 = 0.f;
#pragma unroll
        for (int j = 0; j < 4; ++j) { v[j] = v[j] - mean; s2 += (v[j].x * v[j].x + v[j].y * v[j].y) + (v[j].z * v[j].z + v[j].w * v[j].w); }
        const float rstd = 1.f / sqrtf(wave_sum(s2) * (1.f / DM) + LN_EPS);
        GAS f32x4* o4 = (GAS f32x4*)(H1 + (size_t)m * DM) + lane;
        GAS v2u* o2 = (GAS v2u*)(H1B + (size_t)m * DM) + lane;
#pragma unroll
        for (int j = 0; j < 4; ++j) { const f32x4 y = v[j] * rstd * gv[j] + bv[j]; o4[64 * j] = y; v2u w; w.x = cvtpk(y.x, y.y); w.y = cvtpk(y.z, y.w); o2[64 * j] = w; }
    }
}

namespace att {
typedef short v4i16_t __attribute__((ext_vector_type(4)));
constexpr int KP = 144;
constexpr int D_V = 2 * 64 * KP, D_BUF = D_V + 16384;
constexpr int S_V = 64 * KP, S_BUF = S_V + 8192;
__device__ __forceinline__ s16x4 vtr(const LAS unsigned char* p) { return __builtin_bit_cast(s16x4, __builtin_amdgcn_ds_read_tr16_b64_v4i16((LAS v4i16_t*)p)); }
__device__ __forceinline__ float swapsum(float v) { auto rr = __builtin_amdgcn_permlane32_swap(__float_as_uint(v), __float_as_uint(v), false, false); return __uint_as_float(rr[0]) + __uint_as_float(rr[1]); }
__device__ __forceinline__ float swapmax(float v) { auto rr = __builtin_amdgcn_permlane32_swap(__float_as_uint(v), __float_as_uint(v), false, false); return fmaxf(__uint_as_float(rr[0]), __uint_as_float(rr[1])); }
#define ATT_MFMA(a, b, c) __builtin_amdgcn_mfma_f32_32x32x16_bf16((a), (b), (c), 0, 0, 0)
#define ATT_PF(S, s) (bf16x8)__builtin_bit_cast(bf16x8, ((v4u){cvtpk(S[8 * (s)], S[8 * (s) + 1]), cvtpk(S[8 * (s) + 2], S[8 * (s) + 3]), cvtpk(S[8 * (s) + 4], S[8 * (s) + 5]), cvtpk(S[8 * (s) + 6], S[8 * (s) + 7])}))

__device__ __forceinline__ void diff_unit(LAS unsigned char* lds, const bf16* proj, bf16* mix, int b, int h, int qt, float lam, float sl2, const float* subg, float gscale) {
    const int tid = opaque_tid(), lane = tid & 63, r32 = lane & 31, hi = lane >> 5;
    const int wid = __builtin_amdgcn_readfirstlane(tid >> 6), mp = wid >> 2, qs = wid & 3;
    const size_t rowbase = (size_t)b * SEQ;
    const int tq = 128 * qt + 32 * qs + r32;
    bf16x8 qf[4];
    { const bf16* Qp = proj + (rowbase + tq) * INW + h * 128 + mp * 64 + 8 * hi;
#pragma unroll
      for (int s = 0; s < 4; ++s) qf[s] = *(const GAS bf16x8*)(Qp + 16 * s); }
    const int krow = tid >> 3, kch = tid & 7, vrow = tid >> 4, vch = tid & 15;
    const bf16* ksrc = proj + (rowbase + krow) * INW + 512 + h * 128 + kch * 8;
    const bf16* vsrc = proj + (rowbase + vrow) * INW + 1024 + h * 128 + vch * 8;
    const int kdst = krow * KP + kch * 16;
    const int vdst = ((vrow >> 3) * 4 + (vch >> 2)) * 512 + (vrow & 7) * 64 + (vch & 3) * 16;
    const int NT = 2 * qt + 2;
    v4u sk1, sk2, sv0, sv1;
#define DLOAD(kt) do { const size_t o_ = (size_t)(kt) * 64 * INW; sk1 = *(const GAS v4u*)(ksrc + o_); sk2 = *(const GAS v4u*)(ksrc + o_ + 64); \
        sv0 = *(const GAS v4u*)(vsrc + o_); sv1 = *(const GAS v4u*)(vsrc + o_ + (size_t)32 * INW); } while (0)
#define DWRITE(buf) do { LAS unsigned char* p_ = lds + (buf) * D_BUF; *(LAS v4u*)(p_ + kdst) = sk1; *(LAS v4u*)(p_ + 64 * KP + kdst) = sk2; \
        *(LAS v4u*)(p_ + D_V + vdst) = sv0; *(LAS v4u*)(p_ + D_V + 8192 + vdst) = sv1; } while (0)
    DLOAD(0); DWRITE(0); __syncthreads();
    float mhat = -1e30f, lsum = 0.f;
    f32x16 O[4];
#pragma unroll
    for (int d = 0; d < 4; ++d) O[d] = (f32x16){};
    for (int kt = 0; kt < NT; ++kt) {
        const int cur = kt & 1;
        if (kt + 1 < NT) DLOAD(kt + 1);
        if (!(kt == NT - 1 && qs < 2)) {
            const LAS unsigned char* Kb = lds + cur * D_BUF + mp * (64 * KP) + r32 * KP + hi * 16;
            const LAS unsigned char* Vb = lds + cur * D_BUF + D_V + (4 * hi + ((lane & 15) >> 2)) * 64 + ((lane >> 4) & 1) * 32 + (lane & 3) * 8;
            f32x16 S0, S1;
            const float base0 = -sl2 * (float)(tq - 64 * kt - 4 * hi);
#pragma unroll
            for (int r = 0; r < 16; ++r) { const float c = (float)((r & 3) + 8 * (r >> 2)); S0[r] = fmaf(sl2, c, base0); S1[r] = fmaf(sl2, c + 32.f, base0); }
#pragma unroll
            for (int s = 0; s < 4; ++s) { const bf16x8 a0 = *(const LAS bf16x8*)(Kb + s * 32), a1 = *(const LAS bf16x8*)(Kb + 32 * KP + s * 32);
                S0 = ATT_MFMA(a0, qf[s], S0); S1 = ATT_MFMA(a1, qf[s], S1); }
            if (kt >= NT - 2) {
                const int kb = 64 * kt + 4 * hi;
#pragma unroll
                for (int r = 0; r < 16; ++r) { const int kv = kb + (r & 3) + 8 * (r >> 2); if (kv > tq) S0[r] = -INFINITY; if (kv + 32 > tq) S1[r] = -INFINITY; }
            }
            float rm = fmaxf(S0[0], S1[0]);
#pragma unroll
            for (int r = 1; r < 16; ++r) rm = fmaxf(rm, fmaxf(S0[r], S1[r]));
            rm = swapmax(rm);
            const float mnew = fmaxf(mhat, rm), f = __builtin_amdgcn_exp2f(mhat - mnew);
            mhat = mnew; lsum *= f;
#pragma unroll
            for (int d = 0; d < 4; ++d)
#pragma unroll
                for (int r = 0; r < 16; ++r) O[d][r] *= f;
            float ps = 0.f;
#pragma unroll
            for (int r = 0; r < 16; ++r) { S0[r] = __builtin_amdgcn_exp2f(S0[r] - mhat); S1[r] = __builtin_amdgcn_exp2f(S1[r] - mhat); ps += S0[r] + S1[r]; }
            lsum += ps;
            bf16x8 pf[4];
            pf[0] = ATT_PF(S0, 0); pf[1] = ATT_PF(S0, 1); pf[2] = ATT_PF(S1, 0); pf[3] = ATT_PF(S1, 1);
#pragma unroll
            for (int d = 0; d < 4; ++d)
#pragma unroll
                for (int ks = 0; ks < 4; ++ks) { const s16x4 lo = vtr(Vb + ((2 * ks) * 4 + d) * 512), up = vtr(Vb + ((2 * ks + 1) * 4 + d) * 512);
                    const bf16x8 vf = (bf16x8){lo[0], lo[1], lo[2], lo[3], up[0], up[1], up[2], up[3]};
                    O[d] = ATT_MFMA(vf, pf[ks], O[d]); }
        }
        if (kt + 1 < NT) DWRITE(cur ^ 1);
        __syncthreads();
    }
#undef DLOAD
#undef DWRITE
    lsum = swapsum(lsum);
    const float inv = 1.0f / lsum;
    LAS float* X = (LAS float*)lds;
    if (mp == 1) {
#pragma unroll
        for (int d = 0; d < 4; ++d)
#pragma unroll
            for (int r = 0; r < 16; ++r) X[(qs * 64 + d * 16 + r) * 64 + lane] = O[d][r] * inv;
    }
    __syncthreads();
    if (mp == 0) {
        float ss = 0.f;
#pragma unroll
        for (int d = 0; d < 4; ++d)
#pragma unroll
            for (int r = 0; r < 16; ++r) { const float v = O[d][r] * inv - lam * X[(qs * 64 + d * 16 + r) * 64 + lane]; O[d][r] = v; ss += v * v; }
        ss = swapsum(ss);
        const float rs = gscale / sqrtf(ss * (1.0f / 128.0f) + RMS_EPS);
        bf16* op = mix + (rowbase + tq) * DM + h * 128 + 4 * hi;
#pragma unroll
        for (int d = 0; d < 4; ++d)
#pragma unroll
            for (int g = 0; g < 4; ++g) { const int dv0 = 32 * d + 8 * g; const f32x4 gv = *(const GAS f32x4*)(subg + dv0 + 4 * hi);
                v2u w; w.x = cvtpk(O[d][4 * g] * rs * gv.x, O[d][4 * g + 1] * rs * gv.y); w.y = cvtpk(O[d][4 * g + 2] * rs * gv.z, O[d][4 * g + 3] * rs * gv.w);
                *(GAS v2u*)(op + dv0) = w; }
    }
    __syncthreads();
}

__device__ __forceinline__ void sb_unit(LAS unsigned char* lds, const bf16* proj, bf16* mix, int b, int g, int qt) {
    const int tid = opaque_tid(), lane = tid & 63, r32 = lane & 31, hi = lane >> 5;
    const int wid = __builtin_amdgcn_readfirstlane(tid >> 6);
    const size_t rowbase = (size_t)b * SEQ;
    const int tq = 256 * qt + 32 * wid + r32;
    bf16x8 qf[4];
    { const bf16* Qp = proj + (rowbase + tq) * INW + 1536 + g * 64 + 8 * hi;
#pragma unroll
      for (int s = 0; s < 4; ++s) qf[s] = *(const GAS bf16x8*)(Qp + 16 * s); }
    const int krow = tid >> 3, kch = tid & 7;
    const bf16* ksrc = proj + (rowbase + krow) * INW + 2048 + g * 64 + kch * 8;
    const bf16* vsrc = proj + (rowbase + krow) * INW + 2560 + g * 64 + kch * 8;
    const int kdst = krow * KP + kch * 16;
    const int vdst = ((krow >> 3) * 2 + (kch >> 2)) * 512 + (krow & 7) * 64 + (kch & 3) * 16;
    const int NT = 4 * qt + 4, ktw = 4 * qt + (wid >> 1);
    v4u sk, sv;
#define SLOAD(kt) do { const size_t o_ = (size_t)(kt) * 64 * INW; sk = *(const GAS v4u*)(ksrc + o_); sv = *(const GAS v4u*)(vsrc + o_); } while (0)
#define SWRITE(buf) do { LAS unsigned char* p_ = lds + (buf) * S_BUF; *(LAS v4u*)(p_ + kdst) = sk; *(LAS v4u*)(p_ + S_V + vdst) = sv; } while (0)
    SLOAD(NT - 1); SWRITE(0); __syncthreads();
    float c2 = 0.f;
    f32x16 O[2];
    O[0] = (f32x16){}; O[1] = (f32x16){};
    for (int i = 0; i < NT; ++i) {
        const int kt = NT - 1 - i, cur = i & 1;
        if (i + 1 < NT) SLOAD(kt - 1);
        if (kt <= ktw) {
            const LAS unsigned char* Kb = lds + cur * S_BUF + r32 * KP + hi * 16;
            const LAS unsigned char* Vb = lds + cur * S_BUF + S_V + (4 * hi + ((lane & 15) >> 2)) * 64 + ((lane >> 4) & 1) * 32 + (lane & 3) * 8;
            f32x16 S0 = (f32x16){}, S1 = (f32x16){};
#pragma unroll
            for (int s = 0; s < 4; ++s) { const bf16x8 a0 = *(const LAS bf16x8*)(Kb + s * 32), a1 = *(const LAS bf16x8*)(Kb + 32 * KP + s * 32);
                S0 = ATT_MFMA(a0, qf[s], S0); S1 = ATT_MFMA(a1, qf[s], S1); }
            const bool diag = (kt == ktw);
            const int kb = 64 * kt + 4 * hi;
            f32x16 x0, x1;
#pragma unroll
            for (int r = 0; r < 16; ++r) { x0[r] = -__builtin_amdgcn_logf(1.0f + __builtin_amdgcn_exp2f(S0[r])); x1[r] = -__builtin_amdgcn_logf(1.0f + __builtin_amdgcn_exp2f(S1[r])); }
            if (diag) {
#pragma unroll
                for (int r = 0; r < 16; ++r) { const int kv = kb + (r & 3) + 8 * (r >> 2); if (kv >= tq) x0[r] = 0.f; if (kv + 32 >= tq) x1[r] = 0.f; }
            }
#pragma unroll
            for (int gq = 0; gq < 4; ++gq) { const int i4 = 4 * gq;
                x0[i4 + 2] += x0[i4 + 3]; x0[i4 + 1] += x0[i4 + 2]; x0[i4] += x0[i4 + 1];
                x1[i4 + 2] += x1[i4 + 3]; x1[i4 + 1] += x1[i4 + 2]; x1[i4] += x1[i4 + 1]; }
            float run = c2;
#pragma unroll
            for (int gq = 3; gq >= 0; --gq) { auto rr = __builtin_amdgcn_permlane32_swap(__float_as_uint(x1[4 * gq]), __float_as_uint(x1[4 * gq]), false, false);
                const float lo = __uint_as_float(rr[0]), up = __uint_as_float(rr[1]); const float off = run + (hi == 0 ? up : 0.f); run += lo + up;
                x1[4 * gq] += off; x1[4 * gq + 1] += off; x1[4 * gq + 2] += off; x1[4 * gq + 3] += off; }
#pragma unroll
            for (int gq = 3; gq >= 0; --gq) { auto rr = __builtin_amdgcn_permlane32_swap(__float_as_uint(x0[4 * gq]), __float_as_uint(x0[4 * gq]), false, false);
                const float lo = __uint_as_float(rr[0]), up = __uint_as_float(rr[1]); const float off = run + (hi == 0 ? up : 0.f); run += lo + up;
                x0[4 * gq] += off; x0[4 * gq + 1] += off; x0[4 * gq + 2] += off; x0[4 * gq + 3] += off; }
            c2 = run;
#pragma unroll
            for (int r = 0; r < 16; ++r) { S0[r] = __builtin_amdgcn_exp2f(S0[r] + x0[r]); S1[r] = __builtin_amdgcn_exp2f(S1[r] + x1[r]); }
            if (diag) {
#pragma unroll
                for (int r = 0; r < 16; ++r) { const int kv = kb + (r & 3) + 8 * (r >> 2); if (kv >= tq) S0[r] = 0.f; if (kv + 32 >= tq) S1[r] = 0.f; }
            }
            bf16x8 pf[4];
            pf[0] = ATT_PF(S0, 0); pf[1] = ATT_PF(S0, 1); pf[2] = ATT_PF(S1, 0); pf[3] = ATT_PF(S1, 1);
#pragma unroll
            for (int d = 0; d < 2; ++d)
#pragma unroll
                for (int ks = 0; ks < 4; ++ks) { const s16x4 lo = vtr(Vb + ((2 * ks) * 2 + d) * 512), up = vtr(Vb + ((2 * ks + 1) * 2 + d) * 512);
                    const bf16x8 vf = (bf16x8){lo[0], lo[1], lo[2], lo[3], up[0], up[1], up[2], up[3]};
                    O[d] = ATT_MFMA(vf, pf[ks], O[d]); }
        }
        if (i + 1 < NT) SWRITE(cur ^ 1);
        __syncthreads();
    }
#undef SLOAD
#undef SWRITE
    bf16* op = mix + (rowbase + tq) * DM + 512 + g * 64 + 4 * hi;
#pragma unroll
    for (int d = 0; d < 2; ++d)
#pragma unroll
        for (int gq = 0; gq < 4; ++gq) { v2u w; w.x = cvtpk(O[d][4 * gq], O[d][4 * gq + 1]); w.y = cvtpk(O[d][4 * gq + 2], O[d][4 * gq + 3]);
            *(GAS v2u*)(op + 32 * d + 8 * gq) = w; }
}
#undef ATT_MFMA
#undef ATT_PF
}

__device__ __forceinline__ void phase_attention(ArgP a, int layer, LAS unsigned char* lds, int vcu) {
    const int lane = opaque_tid() & 63;
    const bf16* proj = (const bf16*)(a->ws + WS_PROJ); bf16* mix = (bf16*)(a->ws + WS_MIX);
    const float linit = 0.8f - 0.6f * expf(-0.3f * (float)layer);
    const float d1 = wave_sum(a->in[2][layer * 64 + lane] * a->in[3][layer * 64 + lane]);
    const float d2 = wave_sum(a->in[4][layer * 64 + lane] * a->in[5][layer * 64 + lane]);
    const float lam = expf(d1) - expf(d2) + linit;
    const float* subg = a->in[6] + layer * 128;
    {
        const int bh = vcu >> 3, s = vcu & 7, b = bh >> 2, h = bh & 3;
        const float sl2 = exp2f(-2.0f * (float)(h + 1)) * LOG2E;
#pragma nounroll
        for (int i = 0; i < 2; ++i) att::diff_unit(lds, proj, mix, b, h, i ? s : 15 - s, lam, sl2, subg, 1.0f - linit);
    }
    {
        const int bg = vcu >> 2, s = vcu & 3, b = bg >> 3, g = bg & 7;
#pragma nounroll
        for (int i = 0; i < 2; ++i) att::sb_unit(lds, proj, mix, b, g, i ? s : 7 - s);
    }
}

namespace peer {
constexpr int SKP = 272;
constexpr int L_CAND = 2 * 128 * SKP;
__device__ __forceinline__ unsigned f2mono(float f) { const unsigned u = __float_as_uint(f); return u ^ ((unsigned)((int)u >> 31) | 0x80000000u); }
__device__ __forceinline__ float mono2f(unsigned m) { const unsigned u = (m & 0x80000000u) ? (m ^ 0x80000000u) : ~m; return __uint_as_float(u); }
__device__ __forceinline__ float key_score(unsigned k) { return mono2f((k & ~127u) | 64u); }
__device__ __forceinline__ void sort16_desc(unsigned (&v)[16]) {
#pragma unroll
    for (int k = 2; k <= 16; k <<= 1)
#pragma unroll
        for (int j = k >> 1; j > 0; j >>= 1)
#pragma unroll
            for (int i = 0; i < 16; ++i) { const int p = i ^ j; if (p > i) { const bool desc = ((i & k) == 0); const unsigned a = v[i], b = v[p];
                const unsigned mx = a > b ? a : b, mn = a > b ? b : a; v[i] = desc ? mx : mn; v[p] = desc ? mn : mx; } }
}
__device__ __forceinline__ void merge16_desc(unsigned (&a)[16], const unsigned (&b)[16]) {
#pragma unroll
    for (int i = 0; i < 16; ++i) a[i] = a[i] > b[15 - i] ? a[i] : b[15 - i];
#pragma unroll
    for (int j = 8; j > 0; j >>= 1)
#pragma unroll
        for (int i = 0; i < 16; ++i) { const int p = i ^ j; if (p > i) { const unsigned x = a[i], y = a[p]; a[i] = x > y ? x : y; a[p] = x > y ? y : x; } }
}
__device__ __forceinline__ void score_unit(LAS unsigned char* lds, const bf16* qp, const bf16* skl, int* idxo, float* gateo, int tile, int h) {
    const int tid = opaque_tid(), lane = tid & 63, r32 = lane & 31, hi = lane >> 5;
    const int wid = __builtin_amdgcn_readfirstlane(tid >> 6), p = wid >> 2, tg = wid & 3;
#pragma unroll
    for (int j = 0; j < 8; ++j) { const int c = tid + 512 * j, row = c >> 4, ch = c & 15;
        *(LAS v4u*)(lds + row * SKP + ch * 16) = *(const GAS v4u*)(skl + ((size_t)h * 256 + row) * 128 + ch * 8); }
    bf16x8 qf[8];
    { const bf16* Qp = qp + (size_t)(tile * 128 + tg * 32 + r32) * QW + h * 256 + p * 128 + 8 * hi;
#pragma unroll
      for (int s = 0; s < 8; ++s) qf[s] = *(const GAS bf16x8*)(Qp + 16 * s); }
    __syncthreads();
    unsigned v[4][16];
#pragma unroll
    for (int blk = 0; blk < 4; ++blk) {
        f32x16 S = (f32x16){};
        const LAS unsigned char* kb = lds + (p * 128 + blk * 32 + r32) * SKP + hi * 16;
#pragma unroll
        for (int s = 0; s < 8; ++s) S = __builtin_amdgcn_mfma_f32_32x32x16_bf16(*(const LAS bf16x8*)(kb + s * 32), qf[s], S, 0, 0, 0);
#pragma unroll
        for (int r = 0; r < 16; ++r) v[blk][r] = (f2mono(S[r]) & ~127u) | (unsigned)(127 - (32 * blk + (r & 3) + 8 * (r >> 2)) - 4 * hi);
    }
    sort16_desc(v[0]); sort16_desc(v[1]); sort16_desc(v[2]); sort16_desc(v[3]);
    merge16_desc(v[0], v[1]); merge16_desc(v[2], v[3]); merge16_desc(v[0], v[2]);
    unsigned lo[16], up[16];
#pragma unroll
    for (int i = 0; i < 16; ++i) { auto rr = __builtin_amdgcn_permlane32_swap(v[0][i], v[0][i], false, false); lo[i] = rr[0]; up[i] = rr[1]; }
    merge16_desc(lo, up);
    LAS unsigned* cand = (LAS unsigned*)(lds + L_CAND);
    if (hi == 0) { LAS v4u* cp = (LAS v4u*)(cand + ((tg * 32 + r32) * 2 + p) * 16);
#pragma unroll
        for (int i = 0; i < 4; ++i) cp[i] = (v4u){lo[4 * i], lo[4 * i + 1], lo[4 * i + 2], lo[4 * i + 3]}; }
    __syncthreads();
    if (tid < 128) {
        const LAS unsigned* c1 = cand + (tid * 2) * 16; const LAS unsigned* c2 = c1 + 16;
        float s1[16], s2[16];
#pragma unroll
        for (int i = 0; i < 16; ++i) { s1[i] = key_score(c1[i]); s2[i] = key_score(c2[i]); }
        unsigned w[4][16];
#pragma unroll
        for (int n = 0; n < 64; ++n) w[n >> 4][n & 15] = 0u;
        { int n = 0;
#pragma unroll
          for (int i = 0; i < 16; ++i)
#pragma unroll
              for (int j = 0; j < 16; ++j) if ((i + 1) * (j + 1) <= 16) { w[n >> 4][n & 15] = (f2mono(s1[i] + s2[j]) & ~255u) | (unsigned)(255 - (i * 16 + j)); ++n; } }
        sort16_desc(w[0]); sort16_desc(w[1]); sort16_desc(w[2]); sort16_desc(w[3]);
        merge16_desc(w[0], w[1]); merge16_desc(w[2], w[3]); merge16_desc(w[0], w[2]);
        float sm[16]; int ix[16]; float mx = -1e30f;
#pragma unroll
        for (int k = 0; k < 16; ++k) { const unsigned code = 255u - (w[0][k] & 255u); const unsigned e1 = c1[code >> 4], e2 = c2[code & 15];
            sm[k] = key_score(e1) + key_score(e2); ix[k] = (int)((127u - (e1 & 127u)) * 128u + (127u - (e2 & 127u))); mx = fmaxf(mx, sm[k]); }
        float den = 0.f;
#pragma unroll
        for (int k = 0; k < 16; ++k) { sm[k] = __builtin_amdgcn_exp2f((sm[k] - mx) * LOG2E); den += sm[k]; }
        const float rden = 1.0f / den;
        const size_t o = (size_t)(tile * 128 + tid) * NSEL + h * 16;
#pragma unroll
        for (int i = 0; i < 4; ++i) { *(GAS v4u*)(idxo + o + 4 * i) = (v4u){(unsigned)ix[4 * i], (unsigned)ix[4 * i + 1], (unsigned)ix[4 * i + 2], (unsigned)ix[4 * i + 3]};
            *(GAS f32x4*)(gateo + o + 4 * i) = (f32x4){sm[4 * i] * rden, sm[4 * i + 1] * rden, sm[4 * i + 2] * rden, sm[4 * i + 3] * rden}; }
    }
    __syncthreads();
}
}

__device__ __forceinline__ void phase_score(ArgP a, int layer, LAS unsigned char* lds, int vcu, int G) {
    const bf16* qp = (const bf16*)(a->ws + WS_QP); const bf16* skl = (const bf16*)(a->ws + WS_SK) + (size_t)layer * 8 * 2 * 128 * 128;
#pragma nounroll
    for (int u = vcu * 4; u < vcu * 4 + 4; ++u) peer::score_unit(lds, qp, skl, (int*)(a->ws + WS_IDX), (float*)(a->ws + WS_GATE), u >> 3, u & 7);
    (void)G;
}

__device__ __forceinline__ float gelu_erf(float x) { return 0.5f * x * (1.0f + erff(x * 0.70710678118654752f)); }
constexpr int ROWB = DM / 2;
struct GBatch { v2u u[16], v[16]; float su, sv, g; };
__device__ __forceinline__ void gather_load(GBatch& B, __amdgpu_buffer_rsrc_t ru, __amdgpu_buffer_rsrc_t rv, const float* USC, const float* VSC, int ireg, float greg, int l0, int lane) {
    const unsigned loff = (unsigned)lane * 8u;
#pragma unroll
    for (int k = 0; k < 16; ++k) { const unsigned eo = (unsigned)__builtin_amdgcn_readlane(ireg, l0 + k) * (unsigned)ROWB;
        B.u[k] = __builtin_bit_cast(v2u, __builtin_amdgcn_raw_buffer_load_b64(ru, loff, eo, 0)); B.v[k] = __builtin_bit_cast(v2u, __builtin_amdgcn_raw_buffer_load_b64(rv, loff, eo, 0)); }
    const int el = __shfl(ireg, l0 + (lane >> 2));
    B.su = USC[el]; B.sv = VSC[el]; B.g = __shfl(greg, l0 + (lane >> 2));
}
__device__ __forceinline__ void fp4_dec8(unsigned w, f32x2_t (&o)[4]) { o[0] = __builtin_amdgcn_cvt_scalef32_pk_f32_fp4(w, 1.0f, 0); o[1] = __builtin_amdgcn_cvt_scalef32_pk_f32_fp4(w, 1.0f, 1); o[2] = __builtin_amdgcn_cvt_scalef32_pk_f32_fp4(w, 1.0f, 2); o[3] = __builtin_amdgcn_cvt_scalef32_pk_f32_fp4(w, 1.0f, 3); }
__device__ __forceinline__ void gather_compute(const GBatch& B, const f32x2_t (&xp)[8], f32x2_t (&y)[8], int lane) {
    float d[16];
#pragma unroll
    for (int k = 0; k < 16; ++k) { f32x2_t acc = {0.f, 0.f};
#pragma unroll
        for (int i = 0; i < 2; ++i) { f32x2_t q[4]; fp4_dec8(B.u[k][i], q);
#pragma unroll
            for (int b = 0; b < 4; ++b) acc = q[b] * xp[4 * i + b] + acc; }
        d[k] = acc.x + acc.y; }
    float r8[8], r4[4], r2[2];
#pragma unroll
    for (int j = 0; j < 8; ++j) { auto rr = __builtin_amdgcn_permlane32_swap(__float_as_uint(d[j]), __float_as_uint(d[8 + j]), false, false); r8[j] = __uint_as_float(rr[0]) + __uint_as_float(rr[1]); }
#pragma unroll
    for (int j = 0; j < 4; ++j) { auto rr = __builtin_amdgcn_permlane16_swap(__float_as_uint(r8[j]), __float_as_uint(r8[4 + j]), false, false); r4[j] = __uint_as_float(rr[0]) + __uint_as_float(rr[1]); }
    const bool b3 = (lane >> 3) & 1, b2 = (lane >> 2) & 1;
#pragma unroll
    for (int j = 0; j < 2; ++j) r2[j] = (b3 ? r4[2 + j] : r4[j]) + __shfl_xor(b3 ? r4[j] : r4[2 + j], 8);
    float tot = (b2 ? r2[1] : r2[0]) + __shfl_xor(b2 ? r2[0] : r2[1], 4);
    tot += __shfl_xor(tot, 2); tot += __shfl_xor(tot, 1);
    const float c = B.g * gelu_erf(tot * B.su) * B.sv;
#pragma unroll
    for (int k = 0; k < 16; ++k) { const float ck = __uint_as_float(__builtin_amdgcn_readlane(__float_as_uint(c), 4 * k)); const f32x2_t c2 = {ck, ck};
#pragma unroll
        for (int i = 0; i < 2; ++i) { f32x2_t q[4]; fp4_dec8(B.v[k][i], q);
#pragma unroll
            for (int b = 0; b < 4; ++b) y[4 * i + b] = q[b] * c2 + y[4 * i + b]; } }
}

__device__ __forceinline__ void phase_gather(ArgP a, int layer, int vcu, int G) {
    const int tid = opaque_tid(), lane = tid & 63, wave = __builtin_amdgcn_readfirstlane(tid >> 6);
    const float* H1 = (const float*)(a->ws + WS_H1); const int* IDX = (const int*)(a->ws + WS_IDX); const float* GATE = (const float*)(a->ws + WS_GATE);
    const __amdgpu_buffer_rsrc_t EU = __builtin_amdgcn_make_buffer_rsrc((void*)(a->ws + WS_EU + (size_t)layer * NEXP * ROWB), 0, NEXP * ROWB, 0x00020000);
    const __amdgpu_buffer_rsrc_t EV = __builtin_amdgcn_make_buffer_rsrc((void*)(a->ws + WS_EV + (size_t)layer * NEXP * ROWB), 0, NEXP * ROWB, 0x00020000);
    const float* USC = (const float*)(a->ws + WS_USC) + layer * NEXP; const float* VSC = (const float*)(a->ws + WS_VSC) + layer * NEXP;
    const float* g2 = a->in[14] + layer * DM; const float* b2 = a->in[15] + layer * DM;
    float* Hout = a->out; bf16* HB = (bf16*)(a->ws + WS_HB);
    const int gw = vcu * NWAVES + wave, NGW = G * NWAVES;
    for (int t = gw; t < M; t += NGW) {
        const GAS f32x4* xr = (const GAS f32x4*)(H1 + (size_t)t * DM) + 4 * lane;
        f32x4 xv[4];
#pragma unroll
        for (int q = 0; q < 4; ++q) xv[q] = xr[q];
        f32x2_t xp[8], y[8];
#pragma unroll
        for (int q = 0; q < 4; ++q) { xp[2 * q] = (f32x2_t){xv[q].x, xv[q].y}; xp[2 * q + 1] = (f32x2_t){xv[q].z, xv[q].w}; }
#pragma unroll
        for (int i = 0; i < 8; ++i) y[i] = (f32x2_t){0.f, 0.f};
        const int idx_lo = IDX[(size_t)t * NSEL + lane], idx_hi = IDX[(size_t)t * NSEL + 64 + lane];
        const float gate_lo = GATE[(size_t)t * NSEL + lane], gate_hi = GATE[(size_t)t * NSEL + 64 + lane];
        GBatch A, B;
        gather_load(A, EU, EV, USC, VSC, idx_lo, gate_lo, 0, lane);
#pragma unroll 1
        for (int kb = 0; kb < 8; kb += 2) {
            gather_load(B, EU, EV, USC, VSC, kb < 4 ? idx_lo : idx_hi, kb < 4 ? gate_lo : gate_hi, 16 * ((kb + 1) & 3), lane);
            gather_compute(A, xp, y, lane);
            if (kb + 2 < 8) gather_load(A, EU, EV, USC, VSC, kb + 2 < 4 ? idx_lo : idx_hi, kb + 2 < 4 ? gate_lo : gate_hi, 16 * ((kb + 2) & 3), lane);
            gather_compute(B, xp, y, lane);
        }
        float z[16];
#pragma unroll
        for (int q = 0; q < 4; ++q) { z[4 * q] = ALPHA * xv[q].x + y[2 * q].x; z[4 * q + 1] = ALPHA * xv[q].y + y[2 * q].y; z[4 * q + 2] = ALPHA * xv[q].z + y[2 * q + 1].x; z[4 * q + 3] = ALPHA * xv[q].w + y[2 * q + 1].y; }
        float s = 0.f;
#pragma unroll
        for (int i = 0; i < 16; ++i) s += z[i];
        const float mean = wave_sum(s) * (1.f / DM); float s2 = 0.f;
#pragma unroll
        for (int i = 0; i < 16; ++i) { z[i] -= mean; s2 += z[i] * z[i]; }
        const float rstd = 1.f / sqrtf(wave_sum(s2) * (1.f / DM) + LN_EPS);
        const GAS f32x4* gp = (const GAS f32x4*)g2 + 4 * lane; const GAS f32x4* bp = (const GAS f32x4*)b2 + 4 * lane;
        f32x4 o[4];
#pragma unroll
        for (int q = 0; q < 4; ++q) { const f32x4 gv = gp[q], bv = bp[q];
            o[q] = (f32x4){z[4 * q] * rstd * gv.x + bv.x, z[4 * q + 1] * rstd * gv.y + bv.y, z[4 * q + 2] * rstd * gv.z + bv.z, z[4 * q + 3] * rstd * gv.w + bv.w}; }
        GAS f32x4* op = (GAS f32x4*)(Hout + (size_t)t * DM) + 4 * lane;
#pragma unroll
        for (int q = 0; q < 4; ++q) op[q] = o[q];
        GAS v4u* hp = (GAS v4u*)(HB + (size_t)t * DM) + 2 * lane;
        hp[0] = (v4u){cvtpk(o[0].x, o[0].y), cvtpk(o[0].z, o[0].w), cvtpk(o[1].x, o[1].y), cvtpk(o[1].z, o[1].w)};
        hp[1] = (v4u){cvtpk(o[2].x, o[2].y), cvtpk(o[2].z, o[2].w), cvtpk(o[3].x, o[3].y), cvtpk(o[3].z, o[3].w)};
    }
}

constexpr int PH_PER_LAYER = 7, NPHASE = 1 + DEPTH * PH_PER_LAYER;
#ifndef REPMASK
#define REPMASK 0
#endif
#ifndef PHMASK
#define PHMASK 0xFF
#endif
constexpr int NVCU = 256;

__global__ void __launch_bounds__(NTHR, 2) fwd_kernel(Args args) {
    extern __shared__ __attribute__((aligned(16))) unsigned char lds_raw[];
    LAS unsigned char* lds = (LAS unsigned char*)lds_raw;
    const int tid = threadIdx.x;
    const int G = gridDim.x; const int bx = blockIdx.x; const int vcu = (G % 8 == 0) ? (bx % 8) * (G / 8) + bx / 8 : bx;
    for (int u = tid; u < (LDS_BYTES - LDSCTL_OFF) / 4; u += NTHR) ((LAS unsigned*)(lds + LDSCTL_OFF))[u] = 0u;
    __syncthreads();
#if MK_SINGLE
    XcdBarrier bar = xcd_barrier_post((unsigned*)(arg_ptr()->ws + WS_CTL) + CW_BAR, (volatile LAS unsigned*)(lds + MISC_OFF) + 8);
#endif
    const int lo = arg_ptr()->ph_lo, hi = arg_ptr()->ph_hi;
    const int repmask = arg_ptr()->rep_mask;
#pragma nounroll
    for (int ph = lo; ph < hi; ++ph) {
        const int layer = (ph - 1) / PH_PER_LAYER, sub = ph == 0 ? 7 : (ph - 1) % PH_PER_LAYER;
#pragma nounroll
        for (int rep = 0; rep <= ((repmask >> sub) & 1); ++rep) {
#if MK_SINGLE
            if (ph > lo || rep > 0) { if (ph == 1 && rep == 0) cg::this_grid().sync(); else xcd_barrier(bar); }
#endif
            if (sub == 7) { if (PHMASK & 128) phase_prologue(arg_ptr(), lds, vcu, G); }
            else if (sub == 0) { if (PHMASK & 1) {
                unsigned char* ws = arg_ptr()->ws;
                pg8::Gemm g{(const pg8::bf16_t*)(ws + WS_HB), (const pg8::bf16_t*)(ws + WS_WIN) + (size_t)layer * INW * DM, M, INW, DM};
                pg8::StaticOrder S; S.init(M, INW, G, bx);
                pg8::EpiProj E{(pg8::bf16_t*)(ws + WS_PROJ), QSCALE};
                pg8::gemm_phase<pg8::EpiProj, pg8::StaticOrder, true, true>(lds, g, S, E); }
            } else if (sub == 1) { if (PHMASK & 2) {
                for (int v = vcu; v < NVCU; v += G) phase_attention(arg_ptr(), layer, lds, v); }
            } else if (sub == 2) { if (PHMASK & 4) {
                ArgP ap = arg_ptr(); unsigned char* ws = ap->ws;
                const float* hres = (layer == 0) ? ap->in[0] : ap->out;
                pg8::Gemm g{(const pg8::bf16_t*)(ws + WS_MIX), (const pg8::bf16_t*)(ws + WS_WO) + (size_t)layer * DM * DM, M, DM, DM};
                pg8::StaticOrder S; S.init(M, DM, G, bx);
                pg8::EpiResid E{hres, (float*)(ws + WS_Z), ALPHA};
                pg8::gemm_phase<pg8::EpiResid, pg8::StaticOrder, true, true>(lds, g, S, E); }
            } else if (sub == 3) { if (PHMASK & 8) {
                ArgP ap = arg_ptr(); unsigned char* ws = ap->ws;
                phase_ln1((const float*)(ws + WS_Z), ap->in[8] + layer * DM, ap->in[9] + layer * DM, (float*)(ws + WS_H1), (bf16*)(ws + WS_H1B), vcu, G); }
            } else if (sub == 4) { if (PHMASK & 16) {
                unsigned char* ws = arg_ptr()->ws;
                pg8::Gemm g{(const pg8::bf16_t*)(ws + WS_H1B), (const pg8::bf16_t*)(ws + WS_WQ) + (size_t)layer * QW * DM, M, QW, DM};
                pg8::StaticOrder S; S.init(M, QW, G, bx);
                pg8::EpiBf16<0> E{(pg8::bf16_t*)(ws + WS_QP), QW, nullptr, 0, 0, 1.f};
                pg8::gemm_phase<pg8::EpiBf16<0>, pg8::StaticOrder, true, true>(lds, g, S, E); }
            } else if (sub == 5) { if (PHMASK & 32) {
                for (int v = vcu; v < NVCU; v += G) phase_score(arg_ptr(), layer, lds, v, G); }
            } else { if (PHMASK & 64) {
                phase_gather(arg_ptr(), layer, vcu, G); }
            }
        }
    }
}

extern "C" void kernel_launch(void* const* d_in, const int* in_sizes, int n_in, void* d_out, int out_size, void* d_ws, size_t ws_size, hipStream_t stream) {
    static int grid = 0;
    if (grid == 0) {
        if (n_in != 16 || in_sizes[0] != M * DM || out_size != M * DM || ws_size < WS_END) { fprintf(stderr, "kernel_launch: unexpected shapes (n_in %d, in0 %d, out %d, ws %zu)\n", n_in, n_in > 0 ? in_sizes[0] : -1, out_size, ws_size); grid = -1; return; }
        int dev = 0, cus = 0, per_cu = 0;
        if (hipGetDevice(&dev) != hipSuccess || hipDeviceGetAttribute(&cus, hipDeviceAttributeMultiprocessorCount, dev) != hipSuccess) { grid = -1; return; }
        if (hipFuncSetAttribute((const void*)fwd_kernel, hipFuncAttributeMaxDynamicSharedMemorySize, LDS_BYTES) != hipSuccess) { fprintf(stderr, "kernel_launch: hipFuncSetAttribute failed\n"); grid = -1; return; }
        if (hipOccupancyMaxActiveBlocksPerMultiprocessor(&per_cu, (const void*)fwd_kernel, NTHR, LDS_BYTES) != hipSuccess || per_cu < 1) { fprintf(stderr, "kernel_launch: occupancy query says %d blocks per CU\n", per_cu); (void)hipGetLastError(); grid = -1; return; }
        grid = cus;
        if (grid > NVCU) grid = NVCU;
    }
    if (grid < 0) return;
    (void)hipMemsetAsync((char*)d_ws + WS_CTL, 0, CTL_ZERO_BYTES, stream);
    Args a{};
    for (int i = 0; i < 16; ++i) a.in[i] = (const float*)d_in[i];
    a.out = (float*)d_out; a.ws = (unsigned char*)d_ws; a.rep_mask = REPMASK; a.pad = 0;
#if MK_SINGLE
    a.ph_lo = 0; a.ph_hi = NPHASE;
    void* params[] = {&a};
    hipError_t e = hipLaunchCooperativeKernel((const void*)fwd_kernel, dim3(grid), dim3(NTHR), params, LDS_BYTES, stream);
    if (e != hipSuccess) fprintf(stderr, "kernel_launch: cooperative launch failed: %s (grid %d)\n", hipGetErrorString(e), grid);
#else
    for (int ph = 0; ph < NPHASE; ++ph) { a.ph_lo = ph; a.ph_hi = ph + 1; hipLaunchKernelGGL(fwd_kernel, dim3(grid), dim3(NTHR), LDS_BYTES, stream, a); }
#endif
}
```

```cpp
#include <hip/hip_runtime.h>
#include <hip/hip_cooperative_groups.h>
#include <cstdio>
#include <cstdint>
#ifndef MK_SINGLE
#define MK_SINGLE 1
#endif
__device__ __forceinline__ int opaque_tid() { int t = threadIdx.x; asm volatile("" : "+v"(t)); return t; }
namespace pg8 {
#define PG8_LAS __attribute__((address_space(3)))
typedef unsigned short bf16_t;
typedef short bf16x8 __attribute__((ext_vector_type(8)));
typedef float f32x4 __attribute__((ext_vector_type(4)));
typedef unsigned u32x4 __attribute__((ext_vector_type(4)));
constexpr int BM = 256, BK = 64, HALF = 128, HTB = HALF * BK * 2  , STAGE_BYTES = 8 * HTB, NXCD = 8, WGM = 8;

__host__ __device__ __forceinline__ int lds_byte(int r, int c) { const int st = (r >> 4) * 2 + (c >> 5), rr = r & 15, cc = c & 31, ob = rr * 64 + cc * 2; return st * 1024 + (ob ^ (((ob >> 9) & 1) << 5)); }
__host__ __device__ __forceinline__ void stage_rc(int b, int& R, int& C) { const int st = b / 1024, sb = b % 1024, swz = sb ^ (((sb >> 9) & 1) << 5); R = (st >> 1) * 16 + swz / 64; C = (st & 1) * 32 + (swz % 64) / 2; }
__host__ __device__ __forceinline__ int perm32(int rho) { const int n = rho >> 4, i = rho & 15; return 8 * (i >> 2) + 4 * n + (i & 3); }

struct Unit { int pm, pn; };
struct Gemm { const bf16_t* A; const bf16_t* Bt; int M, N, K; };

struct StaticOrder {
    int nM, nN, nwg, G, c;
    __host__ __device__ void init(int M, int N, int G_, int c_) { nM = M / BM; nN = N / BM; nwg = nM * nN; G = G_; c = c_; }
    __host__ __device__ bool next(int i, Unit& u) const {
        const long L = (long)i * G + c; if (L >= nwg) return false;
        int wgid = (int)L; { const int q = nwg / NXCD, r = nwg % NXCD, xcd = wgid % NXCD, off = wgid / NXCD; wgid = (xcd < r ? xcd * (q + 1) : r * (q + 1) + (xcd - r) * q) + off; }
        const int nig = WGM * nN, gid = wgid / nig, fm = gid * WGM, gsz = (nM - fm) < WGM ? (nM - fm) : WGM;
        u.pm = fm + ((wgid % nig) % gsz); u.pn = (wgid % nig) / gsz; return true;
    }
    __device__ __forceinline__ void a_ready(const Unit&) const {}
    __device__ __forceinline__ void done(const Unit&) const {}
};

__device__ __forceinline__ unsigned cvt_pk_bf16(float lo, float hi) { unsigned r; asm volatile("v_cvt_pk_bf16_f32 %0, %1, %2" : "=v"(r) : "v"(lo), "v"(hi)); return r; }
typedef float f32x2 __attribute__((ext_vector_type(2)));
__device__ __forceinline__ f32x2 gelu_pk(f32x2 v) {
    const f32x2 av = __builtin_elementwise_abs(v), d = av * 0.2316418882f + 1.0f;
    f32x2 t; t.x = __builtin_amdgcn_rcpf(d.x); t.y = __builtin_amdgcn_rcpf(d.y);
    f32x2 q = t * 0.5307027145f + (-0.7265760135f); q = q * t + 0.7107068705f; q = q * t + (-0.142248368f); q = q * t + 0.127414796f; q = q * t;
    const f32x2 s = (v * v) * (-0.72134752044f);
    f32x2 e; e.x = __builtin_amdgcn_exp2f(s.x); e.y = __builtin_amdgcn_exp2f(s.y);
    const f32x2 m = v * (q * e), r = v - m;
    f32x2 o; o.x = v.x < 0.f ? m.x : r.x; o.y = v.y < 0.f ? m.y : r.y; return o;
}

template <int ACT  > struct EpiBf16 {
    static constexpr bool PERM = true, AFTER_DRAIN = false; static_assert(ACT == 0 || ACT == 1, "EpiBf16: ACT is 0 (none) or 1 (gelu_pk)");
    bf16_t* O; int ldc; const float* bias; int split_cols; size_t split_stride; float scale0;
    __device__ __forceinline__ void operator()(const f32x4 (&acc)[2][2][4][2], const Unit& u, int wr, int wc, int fr, int fq) const {
        const int row0 = u.pm * BM + wr * 64 + fr; int colt = u.pn * BM; bf16_t* base = O;
        float sc = 1.f; if (split_cols) { const int t = colt / split_cols; base += (size_t)t * split_stride; colt -= t * split_cols; if (t == 0) sc = scale0; }
        const int col0 = colt + wc * 32 + 8 * fq, bcol0 = u.pn * BM + wc * 32 + 8 * fq;
        f32x4 bv[2][2];
#pragma unroll
        for (int bj = 0; bj < 2; ++bj)
#pragma unroll
            for (int n = 0; n < 2; ++n) bv[bj][n] = bias ? *(const f32x4*)(bias + bcol0 + bj * HALF + 4 * n) : (f32x4){0.f, 0.f, 0.f, 0.f};
#pragma unroll
        for (int ai = 0; ai < 2; ++ai)
#pragma unroll
            for (int m = 0; m < 4; ++m) { bf16_t* rowp = base + (size_t)(row0 + ai * HALF + m * 16) * ldc + col0;
#pragma unroll
                for (int bj = 0; bj < 2; ++bj) { f32x4 v0 = acc[ai][bj][m][0] + bv[bj][0], v1 = acc[ai][bj][m][1] + bv[bj][1];
                    if (ACT == 1) { f32x2 a = gelu_pk((f32x2){v0[0], v0[1]}), b = gelu_pk((f32x2){v0[2], v0[3]}), c = gelu_pk((f32x2){v1[0], v1[1]}), d = gelu_pk((f32x2){v1[2], v1[3]});
                        v0 = (f32x4){a.x, a.y, b.x, b.y}; v1 = (f32x4){c.x, c.y, d.x, d.y}; }
                    v0 = v0 * sc; v1 = v1 * sc; u32x4 w; w.x = cvt_pk_bf16(v0[0], v0[1]); w.y = cvt_pk_bf16(v0[2], v0[3]); w.z = cvt_pk_bf16(v1[0], v1[1]); w.w = cvt_pk_bf16(v1[2], v1[3]);
                    *(u32x4*)(rowp + bj * HALF) = w; } }
    }
};

struct PanelStats {
    unsigned* xbuf;
    unsigned* cnt;
    unsigned* tmo;
    int ntn; float eps;
    unsigned code;
    __device__ __forceinline__ bool run(const f32x4 (&v)[2][2][4][2], const Unit& u, int wr, int wc, int fr, int fq, PG8_LAS unsigned char* lds, int wid, int lane) const {
        typedef float f32x2v __attribute__((ext_vector_type(2)));
        PG8_LAS f32x2v* P = (PG8_LAS f32x2v*)lds;
        PG8_LAS f32x2v* S = (PG8_LAS f32x2v*)(lds + 8192);
        PG8_LAS unsigned* flag = (PG8_LAS unsigned*)(lds + 8192 + 2048);
#pragma unroll
        for (int ai = 0; ai < 2; ++ai)
#pragma unroll
            for (int m = 0; m < 4; ++m) {
                float s = 0.f;
#pragma unroll
                for (int bj = 0; bj < 2; ++bj)
#pragma unroll
                    for (int n = 0; n < 2; ++n) { const f32x4 x = v[ai][bj][m][n]; s += (x[0] + x[1]) + (x[2] + x[3]); }
                s += __shfl_xor(s, 16); s += __shfl_xor(s, 32);
                const float mw = s * (1.0f / 64.0f); float q = 0.f;
#pragma unroll
                for (int bj = 0; bj < 2; ++bj)
#pragma unroll
                    for (int n = 0; n < 2; ++n) { const f32x4 d = v[ai][bj][m][n] - mw; q += (d[0] * d[0] + d[1] * d[1]) + (d[2] * d[2] + d[3] * d[3]); }
                q += __shfl_xor(q, 16); q += __shfl_xor(q, 32);
                if (fq == 0) P[(ai * HALF + wr * 64 + m * 16 + fr) * 4 + wc] = (f32x2v){mw, q};
            }
        asm volatile("s_waitcnt lgkmcnt(0)" ::: "memory"); __builtin_amdgcn_s_barrier(); asm volatile("" ::: "memory");
#if defined(BROKEN_EXCHANGE_NO_WAIT)
#warning BROKEN CONTROL BUILD: the row-statistics exchange does not wait; results are wrong by design
        if (blockIdx.x >= 64) { const long long t0_ = clock64(); while (clock64() - t0_ < 60000) __builtin_amdgcn_s_sleep(8); }
#endif
        const int row = wid * 32 + (lane & 31);
        if (lane < 32) {
            const f32x2v a = P[row * 4 + 0], b = P[row * 4 + 1], c = P[row * 4 + 2], d = P[row * 4 + 3];
            const float mt = (a.x + b.x + c.x + d.x) * 0.25f;
            const float da = a.x - mt, db = b.x - mt, dc = c.x - mt, dd = d.x - mt;
            const float m2 = (a.y + b.y) + (c.y + d.y) + 64.0f * ((da * da + db * db) + (dc * dc + dd * dd));
            unsigned long long* slot = (unsigned long long*)xbuf + ((size_t)(u.pm * BM + row) * 4 + u.pn);
            __hip_atomic_store(slot, ((unsigned long long)__float_as_uint(m2) << 32) | __float_as_uint(mt), __ATOMIC_RELAXED, __HIP_MEMORY_SCOPE_AGENT);
        }
        asm volatile("s_waitcnt vmcnt(0)" ::: "memory");
        if (lane == 0) __hip_atomic_fetch_add(cnt + 64 * u.pm, 1u, __ATOMIC_RELAXED, __HIP_MEMORY_SCOPE_AGENT);
        if (wid == 0) {
            bool dead = false; const unsigned long long t0 = __builtin_amdgcn_s_memrealtime(); const unsigned want = 8u * (unsigned)ntn;
            for (;;) {
#if defined(BROKEN_EXCHANGE_NO_WAIT)
                break;
#endif
                if ((unsigned)__builtin_amdgcn_readfirstlane(__hip_atomic_load(cnt + 64 * u.pm, __ATOMIC_RELAXED, __HIP_MEMORY_SCOPE_AGENT)) >= want) break;
                if (__builtin_amdgcn_s_memrealtime() - t0 > 2000000ull) {
                    if (lane == 0) { unsigned expect = 0u; __hip_atomic_compare_exchange_strong(tmo + 1, &expect, code | (unsigned)(u.pm & 0xff), __ATOMIC_RELAXED, __ATOMIC_RELAXED, __HIP_MEMORY_SCOPE_AGENT);
                                     __hip_atomic_store(tmo, 1u, __ATOMIC_RELAXED, __HIP_MEMORY_SCOPE_AGENT); }
                    dead = true; break; }
                __builtin_amdgcn_s_sleep(2);
            }
            __builtin_amdgcn_fence(__ATOMIC_ACQUIRE, "agent");
            if (lane == 0) flag[0] = dead ? 1u : 0u;
        }
        asm volatile("s_waitcnt vmcnt(0) lgkmcnt(0)" ::: "memory"); __builtin_amdgcn_s_barrier(); asm volatile("" ::: "memory");
        const bool bad = flag[0] != 0u;
        if (lane < 32) {
            const unsigned long long* slot = (const unsigned long long*)xbuf + (size_t)(u.pm * BM + row) * 4; float mt[4], m2[4]; float ms = 0.f;
#pragma unroll
            for (int t = 0; t < 4; ++t) { if (t < ntn) { const unsigned long long w = __hip_atomic_load(slot + t, __ATOMIC_RELAXED, __HIP_MEMORY_SCOPE_AGENT); mt[t] = __uint_as_float((unsigned)w); m2[t] = __uint_as_float((unsigned)(w >> 32)); } else { mt[t] = 0.f; m2[t] = 0.f; } ms += mt[t]; }
            const float mean = ms / (float)ntn; float q = 0.f;
#pragma unroll
            for (int t = 0; t < 4; ++t) if (t < ntn) { const float dm = mt[t] - mean; q += m2[t] + 256.0f * dm * dm; }
            S[row] = (f32x2v){mean, 1.0f / sqrtf(q / (256.0f * (float)ntn) + eps)};
        }
        asm volatile("s_waitcnt lgkmcnt(0)" ::: "memory"); __builtin_amdgcn_s_barrier(); asm volatile("" ::: "memory");
        return bad;
    }
};
struct EpiLnRes {
    static constexpr bool PERM = false, AFTER_DRAIN = true;
    const float* base; float* out; int ldc; const float* bias; PanelStats st; unsigned poison;
    __device__ __forceinline__ void fused(f32x4 (&acc)[2][2][4][2], const Unit& u, int wr, int wc, int fr, int fq, PG8_LAS unsigned char* lds, int wid, int lane) const {
        typedef float f32x2v __attribute__((ext_vector_type(2)));
        const PG8_LAS f32x2v* S = (const PG8_LAS f32x2v*)(lds + 8192);
        const int col0 = u.pn * BM + wc * 32 + 4 * fq;
#pragma unroll
        for (int bj = 0; bj < 2; ++bj)
#pragma unroll
            for (int n = 0; n < 2; ++n) { const f32x4 bv = bias ? *(const f32x4*)(bias + col0 + bj * HALF + n * 16) : (f32x4){0.f, 0.f, 0.f, 0.f};
#pragma unroll
                for (int ai = 0; ai < 2; ++ai)
#pragma unroll
                    for (int m = 0; m < 4; ++m) acc[ai][bj][m][n] += bv; }
        f32x4 pre[4][2][2];
#pragma unroll
        for (int m = 0; m < 4; ++m) { const size_t off = (size_t)(u.pm * BM + wr * 64 + m * 16 + fr) * ldc + col0;
#pragma unroll
            for (int bj = 0; bj < 2; ++bj)
#pragma unroll
                for (int n = 0; n < 2; ++n) pre[m][bj][n] = *(const f32x4*)(base + off + bj * HALF + n * 16); }
        const bool bad = st.run(acc, u, wr, wc, fr, fq, lds, wid, lane) || poison != 0u;
        const float qnan = __builtin_nanf("");
#pragma unroll
        for (int ai = 0; ai < 2; ++ai)
#pragma unroll
            for (int m = 0; m < 4; ++m) { const int r = ai * HALF + wr * 64 + m * 16 + fr; const f32x2v sr = S[r]; const size_t off = (size_t)(u.pm * BM + r) * ldc + col0;
#pragma unroll
                for (int bj = 0; bj < 2; ++bj)
#pragma unroll
                    for (int n = 0; n < 2; ++n) { const f32x4 bs = ai == 0 ? pre[m][bj][n] : *(const f32x4*)(base + off + bj * HALF + n * 16); f32x4 o = bs + (acc[ai][bj][m][n] - sr.x) * sr.y;
                        if (bad) o = (f32x4){qnan, qnan, qnan, qnan}; *(f32x4*)(out + off + bj * HALF + n * 16) = o; }
                if (m & 1) asm volatile("" ::: "memory"); }
    }
};
struct EpiLnResLn {
    static constexpr bool PERM = false, AFTER_DRAIN = true;
    const float* base; float* out; bf16_t* xn; int ldc; const float* bias; PanelStats st1, st2; unsigned poison;
    __device__ __forceinline__ void fused(f32x4 (&acc)[2][2][4][2], const Unit& u, int wr, int wc, int fr, int fq, PG8_LAS unsigned char* lds, int wid, int lane) const {
        typedef float f32x2v __attribute__((ext_vector_type(2))); typedef unsigned u32x2v __attribute__((ext_vector_type(2)));
        const PG8_LAS f32x2v* S = (const PG8_LAS f32x2v*)(lds + 8192);
        const int col0 = u.pn * BM + wc * 32 + 4 * fq;
#pragma unroll
        for (int bj = 0; bj < 2; ++bj)
#pragma unroll
            for (int n = 0; n < 2; ++n) { const f32x4 bv = bias ? *(const f32x4*)(bias + col0 + bj * HALF + n * 16) : (f32x4){0.f, 0.f, 0.f, 0.f};
#pragma unroll
                for (int ai = 0; ai < 2; ++ai)
#pragma unroll
                    for (int m = 0; m < 4; ++m) acc[ai][bj][m][n] += bv; }
        bool bad = st1.run(acc, u, wr, wc, fr, fq, lds, wid, lane) || poison != 0u;
        const float qnan = __builtin_nanf("");
#pragma unroll
        for (int ai = 0; ai < 2; ++ai)
#pragma unroll
            for (int m = 0; m < 4; ++m) { const int r = ai * HALF + wr * 64 + m * 16 + fr; const f32x2v sr = S[r]; const size_t off = (size_t)(u.pm * BM + r) * ldc + col0;
#pragma unroll
                for (int bj = 0; bj < 2; ++bj)
#pragma unroll
                    for (int n = 0; n < 2; ++n) { const f32x4 bs = *(const f32x4*)(base + off + bj * HALF + n * 16); acc[ai][bj][m][n] = bs + (acc[ai][bj][m][n] - sr.x) * sr.y; }
                asm volatile("" : "+v"(acc[ai][0][m][0]), "+v"(acc[ai][0][m][1]), "+v"(acc[ai][1][m][0]), "+v"(acc[ai][1][m][1]));
                if (m & 1) asm volatile("" ::: "memory"); }
        const bool bad1 = bad;
        bad = st2.run(acc, u, wr, wc, fr, fq, lds, wid, lane) || bad;
#pragma unroll
        for (int ai = 0; ai < 2; ++ai)
#pragma unroll
            for (int m = 0; m < 4; ++m) { const int r = ai * HALF + wr * 64 + m * 16 + fr; const f32x2v sr = S[r]; const size_t off = (size_t)(u.pm * BM + r) * ldc + col0;
#pragma unroll
                for (int bj = 0; bj < 2; ++bj)
#pragma unroll
                    for (int n = 0; n < 2; ++n) { const f32x4 x1 = acc[ai][bj][m][n]; *(f32x4*)(out + off + bj * HALF + n * 16) = bad1 ? (f32x4){qnan, qnan, qnan, qnan} : x1;
                        const f32x4 o = (x1 - sr.x) * sr.y; u32x2v w; w.x = cvt_pk_bf16(o[0], o[1]); w.y = cvt_pk_bf16(o[2], o[3]);
                        if (bad) { w.x = 0x7fc07fc0u; w.y = 0x7fc07fc0u; } *(u32x2v*)(xn + off + bj * HALF + n * 16) = w; }
                asm volatile("" ::: "memory"); }
    }
};

template <class Epi, class Sched, bool ALIGN_EPI = false, bool SP2 = false>
__device__ __forceinline__ void gemm_phase(PG8_LAS unsigned char* lds, const Gemm g, const Sched& S, const Epi& E) {
    const int tid = opaque_tid(), wid = __builtin_amdgcn_readfirstlane(tid >> 6), lane = tid & 63, wr = wid >> 2, wc = wid & 3, fr = lane & 15, fq = lane >> 4;
    const int K = g.K, nt = K / BK;
    unsigned voffA[2], voffB[2];
#pragma unroll
    for (int i = 0; i < 2; ++i) { int R, C; stage_rc(tid * 16 + i * 8192, R, C); const int Rb = Epi::PERM ? ((R & ~31) + perm32(R & 31)) : R;
        voffA[i] = (unsigned)(R * K + C) * 2u; voffB[i] = (unsigned)(Rb * K + C) * 2u; }
    const size_t kstep = (size_t)(BK * 2);
    const size_t hstep = (size_t)HALF * K * 2;
    const size_t tstep = 2 * hstep;
    const unsigned ldsw = (unsigned)wid * 1024u;
    const int aoff = lds_byte(wr * 64 + fr, fq * 8), boff = lds_byte(wc * 32 + fr, fq * 8);
#define PG8_SA(b, h) (((b) * 2 + (h)) * HTB)
#define PG8_SB(b, h) ((4 + (b) * 2 + (h)) * HTB)
#define PG8_STAGE(bufoff, gbase, voff) do { _Pragma("unroll") for (int _i = 0; _i < 2; ++_i) \
        __builtin_amdgcn_global_load_lds((const unsigned*)((const char*)(gbase) + (voff)[_i]), (PG8_LAS unsigned*)(lds + (bufoff) + ldsw + _i * 8192), 16, 0, 0); } while (0)
#define PG8_LDA(dst, b, h) do { _Pragma("unroll") for (int m = 0; m < 4; ++m) _Pragma("unroll") for (int k = 0; k < 2; ++k) dst[m][k] = *(const PG8_LAS bf16x8*)(lds + PG8_SA(b, h) + aoff + m * 2048 + k * 1024); } while (0)
#define PG8_LDB(dst, b, h) do { _Pragma("unroll") for (int n = 0; n < 2; ++n) _Pragma("unroll") for (int k = 0; k < 2; ++k) dst[n][k] = *(const PG8_LAS bf16x8*)(lds + PG8_SB(b, h) + boff + n * 2048 + k * 1024); } while (0)
#define PG8_MMA(ai, bj, At, Bt) do { __builtin_amdgcn_s_setprio(1); _Pragma("unroll") for (int m = 0; m < 4; ++m) _Pragma("unroll") for (int n = 0; n < 2; ++n) _Pragma("unroll") for (int k = 0; k < 2; ++k) \
        acc[ai][bj][m][n] = __builtin_amdgcn_mfma_f32_16x16x32_bf16(Bt[n][k], At[m][k], acc[ai][bj][m][n], 0, 0, 0); __builtin_amdgcn_s_setprio(0); } while (0)
#define PG8_WAIT_V(n) asm volatile("s_waitcnt vmcnt(" #n ")" ::: "memory")
#define PG8_WAIT_L(n) asm volatile("s_waitcnt lgkmcnt(" #n ")" ::: "memory")
#define PG8_BAR __builtin_amdgcn_s_barrier()
#define PG8_SCHED __builtin_amdgcn_sched_barrier(0)
    Unit cur, nxt; int ui = 0;
    if (!S.next(0, cur)) return;
    f32x4 acc[2][2][4][2];
#pragma unroll
    for (int a = 0; a < 2; ++a)
#pragma unroll
        for (int b = 0; b < 2; ++b)
#pragma unroll
            for (int m = 0; m < 4; ++m)
#pragma unroll
                for (int n = 0; n < 2; ++n) acc[a][b][m][n] = (f32x4){0.f, 0.f, 0.f, 0.f};
    bf16x8 At[4][2], B0[2][2], B1[2][2];
    const char* cA = (const char*)g.A + (size_t)cur.pm * tstep; const char* cB = (const char*)g.Bt + (size_t)cur.pn * tstep;
    S.a_ready(cur);
    if constexpr (SP2) {
        PG8_STAGE(PG8_SB(0, 0), cB, voffB); PG8_STAGE(PG8_SB(0, 1), cB + hstep, voffB); PG8_STAGE(PG8_SA(0, 0), cA, voffA); PG8_STAGE(PG8_SA(0, 1), cA + hstep, voffA);
        if (wr == 1) PG8_BAR;
        PG8_WAIT_V(2); PG8_BAR;
        PG8_STAGE(PG8_SB(1, 0), cB + kstep, voffB); PG8_STAGE(PG8_SA(1, 0), cA + kstep, voffA); PG8_STAGE(PG8_SB(1, 1), cB + hstep + kstep, voffB);
        PG8_WAIT_V(6); PG8_BAR;
    } else {
        PG8_STAGE(PG8_SB(0, 0), cB, voffB); PG8_STAGE(PG8_SA(0, 0), cA, voffA); PG8_STAGE(PG8_SB(0, 1), cB + hstep, voffB); PG8_STAGE(PG8_SA(0, 1), cA + hstep, voffA);
        if (wr == 1) PG8_BAR;
        PG8_WAIT_V(4); PG8_BAR;
        PG8_STAGE(PG8_SB(1, 0), cB + kstep, voffB); PG8_STAGE(PG8_SA(1, 0), cA + kstep, voffA); PG8_STAGE(PG8_SB(1, 1), cB + hstep + kstep, voffB);
        PG8_WAIT_V(6); PG8_BAR;
    }
    for (;;) {
        const bool has_next = S.next(ui + 1, nxt);
        const char* nA = has_next ? (const char*)g.A + (size_t)nxt.pm * tstep : cA; const char* nB = has_next ? (const char*)g.Bt + (size_t)nxt.pn * tstep : cB;
        for (int t = 0; t < nt; t += 2) {
            const bool last = (t == nt - 2);
            const char* a1 = cA + (size_t)(t + 1) * kstep;
            const char* a2 = last ? nA : cA + (size_t)(t + 2) * kstep; const char* b2 = last ? nB : cB + (size_t)(t + 2) * kstep;
            const char* a3 = a2 + kstep; const char* b3 = b2 + kstep;
            if (last && has_next) S.a_ready(nxt);
            if constexpr (SP2) {
            PG8_LDB(B0, 0, 0); PG8_LDB(B1, 0, 1); PG8_SCHED; PG8_LDA(At, 0, 0); PG8_STAGE(PG8_SA(1, 1), a1 + hstep, voffA);
            PG8_WAIT_V(8); PG8_WAIT_L(0); PG8_BAR; PG8_MMA(0, 0, At, B0); PG8_MMA(0, 1, At, B1); PG8_BAR; PG8_SCHED;
            PG8_LDA(At, 0, 1); PG8_STAGE(PG8_SB(0, 0), b2, voffB); PG8_STAGE(PG8_SB(0, 1), b2 + hstep, voffB); PG8_STAGE(PG8_SA(0, 0), a2, voffA);
            PG8_WAIT_V(8); PG8_WAIT_L(0); PG8_BAR; PG8_MMA(1, 0, At, B0); PG8_MMA(1, 1, At, B1); PG8_BAR; PG8_SCHED;
            PG8_LDB(B0, 1, 0); PG8_LDB(B1, 1, 1); PG8_SCHED; PG8_LDA(At, 1, 0); PG8_STAGE(PG8_SA(0, 1), a2 + hstep, voffA);
            PG8_WAIT_V(8); PG8_WAIT_L(0); PG8_BAR; PG8_MMA(0, 0, At, B0); PG8_MMA(0, 1, At, B1); PG8_BAR; PG8_SCHED;
            PG8_LDA(At, 1, 1); PG8_STAGE(PG8_SB(1, 0), b3, voffB); PG8_STAGE(PG8_SB(1, 1), b3 + hstep, voffB); PG8_STAGE(PG8_SA(1, 0), a3, voffA);
            PG8_WAIT_V(8); PG8_WAIT_L(0); PG8_BAR; PG8_MMA(1, 0, At, B0); PG8_MMA(1, 1, At, B1); PG8_BAR; PG8_SCHED;
            } else {
            PG8_LDB(B0, 0, 0); PG8_SCHED; PG8_LDA(At, 0, 0); PG8_STAGE(PG8_SA(1, 1), a1 + hstep, voffA);
            PG8_WAIT_L(8); PG8_BAR; PG8_WAIT_L(0); PG8_MMA(0, 0, At, B0); PG8_BAR; PG8_SCHED;
            PG8_LDB(B1, 0, 1); PG8_STAGE(PG8_SB(0, 0), b2, voffB);
            PG8_BAR; PG8_WAIT_L(0); PG8_MMA(0, 1, At, B1); PG8_BAR;
            PG8_LDA(At, 0, 1); PG8_STAGE(PG8_SA(0, 0), a2, voffA);
            PG8_BAR; PG8_WAIT_L(0); PG8_MMA(1, 0, At, B0); PG8_BAR; PG8_SCHED;
            PG8_STAGE(PG8_SB(0, 1), b2 + hstep, voffB);
            PG8_WAIT_V(6); PG8_BAR; PG8_MMA(1, 1, At, B1); PG8_BAR;
            PG8_LDB(B0, 1, 0); PG8_SCHED; PG8_LDA(At, 1, 0); PG8_STAGE(PG8_SA(0, 1), a2 + hstep, voffA);
            PG8_WAIT_L(8); PG8_BAR; PG8_WAIT_L(0); PG8_MMA(0, 0, At, B0); PG8_BAR; PG8_SCHED;
            PG8_LDB(B1, 1, 1); PG8_STAGE(PG8_SB(1, 0), b3, voffB);
            PG8_BAR; PG8_WAIT_L(0); PG8_MMA(0, 1, At, B1); PG8_BAR;
            PG8_LDA(At, 1, 1); PG8_STAGE(PG8_SA(1, 0), a3, voffA);
            PG8_BAR; PG8_WAIT_L(0); PG8_MMA(1, 0, At, B0); PG8_BAR; PG8_SCHED;
            PG8_STAGE(PG8_SB(1, 1), b3 + hstep, voffB);
            PG8_WAIT_V(6); PG8_BAR; PG8_MMA(1, 1, At, B1); PG8_BAR;
            }
        }
        if constexpr (ALIGN_EPI) { if (wr == 0) PG8_BAR; }
        if constexpr (!Epi::AFTER_DRAIN) { E(acc, cur, wr, wc, fr, fq); S.done(cur); }
        if (!has_next) break;
#pragma unroll
        for (int a = 0; a < 2; ++a)
#pragma unroll
            for (int b = 0; b < 2; ++b)
#pragma unroll
                for (int m = 0; m < 4; ++m)
#pragma unroll
                    for (int n = 0; n < 2; ++n) acc[a][b][m][n] = (f32x4){0.f, 0.f, 0.f, 0.f};
        cur = nxt; cA = nA; cB = nB; ++ui;
        if constexpr (ALIGN_EPI) { if (wr == 1) PG8_BAR; }
    }
    PG8_WAIT_V(0);
    if constexpr (!ALIGN_EPI) { if (wr == 0) PG8_BAR; }
    PG8_BAR;
    if constexpr (Epi::AFTER_DRAIN) { E.fused(acc, cur, wr, wc, fr, fq, lds, wid, lane); S.done(cur); }
#undef PG8_SA
#undef PG8_SB
#undef PG8_STAGE
#undef PG8_LDA
#undef PG8_LDB
#undef PG8_MMA
#undef PG8_WAIT_V
#undef PG8_WAIT_L
#undef PG8_BAR
#undef PG8_SCHED
}
}
#define GAS __attribute__((address_space(1)))
#define LAS __attribute__((address_space(3)))
typedef unsigned short bf16;
typedef unsigned v4u __attribute__((ext_vector_type(4)));
typedef float f32x4 __attribute__((ext_vector_type(4)));
typedef short bf16x8 __attribute__((ext_vector_type(8)));
typedef GAS unsigned gu32;
typedef GAS unsigned long long gu64;
#define RLX_AGENT __ATOMIC_RELAXED, __HIP_MEMORY_SCOPE_AGENT
#define LDS_WAIT() asm volatile("s_waitcnt lgkmcnt(0)" ::: "memory")
#define VM_WAIT() asm volatile("s_waitcnt vmcnt(0)" ::: "memory")
__device__ __forceinline__ unsigned long long rt() { return __builtin_amdgcn_s_memrealtime(); }
__device__ __forceinline__ unsigned f2bf(float f) { unsigned u = __builtin_bit_cast(unsigned, f); return (u + 0x7fffu + ((u >> 16) & 1u)) >> 16; }
__device__ __forceinline__ unsigned pk2(float lo, float hi) { return f2bf(lo) | (f2bf(hi) << 16); }

#define XB_TMO      128
#define XB_XCNT(j)  (256  + 64 * (j))
#define XB_XSUB(j)  (1280 + 64 * (j))
#define XB_XGEN(j)  (2304 + 64 * (j))
#define XB_TOP      3328
#define XB_TOPGEN   3392
#define XCD_BAR_WORDS 3456
#define XB_SPIN_CAP (1u << 18)

__device__ __forceinline__ unsigned xb_ld(unsigned* p)              { return __hip_atomic_load(p, __ATOMIC_RELAXED, __HIP_MEMORY_SCOPE_AGENT); }
__device__ __forceinline__ unsigned xb_add(unsigned* p, unsigned v) { return __hip_atomic_fetch_add(p, v, __ATOMIC_RELAXED, __HIP_MEMORY_SCOPE_AGENT); }
__device__ __forceinline__ unsigned xb_xcc_id() { return (unsigned)__builtin_amdgcn_s_getreg((3 << 11) | 20) & 0xFu; }
#define XB_SPIN(cond, bar) do { unsigned _sp = 0; while (cond) { __builtin_amdgcn_s_sleep(1); \
    if ((++_sp & 255u) == 0u) { if (xb_ld(&(bar)[XB_TMO])) break; if (_sp > XB_SPIN_CAP) { atomicAdd(&(bar)[XB_TMO], 1u); break; } } } } while (0)

struct XcdBarrier {
    unsigned* bar; unsigned x;
    volatile LAS unsigned* st;
};

__device__ __forceinline__ XcdBarrier xcd_barrier_post(unsigned* bar, volatile LAS unsigned* st) {
    XcdBarrier b; b.bar = bar; b.x = xb_xcc_id(); b.st = st;
    if (threadIdx.x == 0) (void)xb_add(&bar[XB_XCNT(b.x)], 1u);
    return b;
}
__device__ __forceinline__ void xcd_barrier_complete(unsigned* bar, unsigned x, unsigned& nloc, unsigned& nx) {
    const unsigned G = gridDim.x * gridDim.y * gridDim.z;
    unsigned sum, cnt, mine, sp = 0u;
    for (;;) {
        sum = 0u; cnt = 0u; mine = 0u;
#pragma nounroll
        for (unsigned j = 0; j < 16; ++j) { const unsigned c = xb_ld(&bar[XB_XCNT(j)]); sum += c; cnt += (c > 0u) ? 1u : 0u; mine = (j == x) ? c : mine; }
        if (sum == G) break;
        __builtin_amdgcn_s_sleep(1);
        if ((++sp & 255u) == 0u) { if (xb_ld(&bar[XB_TMO])) break; if (sp > XB_SPIN_CAP) { atomicAdd(&bar[XB_TMO], 1u); break; } }
    }
    nloc = mine > 0u ? mine : 1u; nx = cnt > 0u ? cnt : 1u;
}

__device__ __forceinline__ void xcd_barrier(const XcdBarrier& b) {
    asm volatile("s_waitcnt vmcnt(0)" ::: "memory");
    __syncthreads();
    if (threadIdx.x == 0) {
        unsigned* bar = b.bar; asm volatile("" : "+s"(bar));
        __builtin_amdgcn_s_waitcnt(0);
        unsigned nloc = b.st[0], nx = b.st[1];
        if (nloc == 0u) { xcd_barrier_complete(bar, b.x, nloc, nx); b.st[0] = nloc; b.st[1] = nx; }
        const unsigned old = xb_add(&bar[XB_XSUB(b.x)], 1u);
        const unsigned gen = old / nloc;
        if (old + 1u == (gen + 1u) * nloc) {
            __builtin_amdgcn_fence(__ATOMIC_RELEASE, "agent");
            asm volatile("s_waitcnt vmcnt(0)" ::: "memory");
            const unsigned og = xb_add(&bar[XB_TOP], 1u);
            const unsigned tg = og / nx;
            if (og + 1u == (tg + 1u) * nx) xb_add(&bar[XB_TOPGEN], 1u);
            else XB_SPIN(xb_ld(&bar[XB_TOPGEN]) == tg, bar);
            __builtin_amdgcn_fence(__ATOMIC_ACQUIRE, "agent");
            xb_add(&bar[XB_XGEN(b.x)], 1u);
            asm volatile("s_waitcnt vmcnt(0)" ::: "memory");
        } else {
            XB_SPIN(xb_ld(&bar[XB_XGEN(b.x)]) == gen, bar);
            __builtin_amdgcn_fence(__ATOMIC_ACQUIRE, "agent");
            asm volatile("s_waitcnt vmcnt(0)" ::: "memory");
        }
    }
    __syncthreads();
}

namespace cg = cooperative_groups;
constexpr int NWAVES = 8, NTHR = 512;
constexpr int BATCH = 8, SEQ = 2048, DM = 1024, M = BATCH * SEQ, DEPTH = 4;
constexpr int INW = 3072, QW = 2048, NEXP = 16384, NSEL = 128;
constexpr float ALPHA = 1.6817928305074292f;
constexpr float LN_EPS = 1e-5f, RMS_EPS = 1e-5f;
constexpr float LOG2E = 1.4426950408889634f;
constexpr float QSCALE = 0.125f * LOG2E;
typedef float f32x16 __attribute__((ext_vector_type(16)));
typedef short s16x4 __attribute__((ext_vector_type(4)));
typedef float f32x2_t __attribute__((ext_vector_type(2)));
typedef __bf16 bf16x2_t __attribute__((ext_vector_type(2)));
typedef unsigned v2u __attribute__((ext_vector_type(2)));

constexpr size_t MiB = 1u << 20;
constexpr size_t WS_CTL = 0, CTL_ZERO_BYTES = 1 * MiB;
constexpr size_t WS_WIN = 2 * MiB;
constexpr size_t WS_WO = 26 * MiB;
constexpr size_t WS_WQ = 34 * MiB;
constexpr size_t WS_SK = 50 * MiB;
constexpr size_t WS_USC = 52 * MiB;
constexpr size_t WS_VSC = 53 * MiB;
constexpr size_t WS_EU = 64 * MiB;
constexpr size_t WS_EV = 192 * MiB;
constexpr size_t WS_HB = 320 * MiB;
constexpr size_t WS_H1B = 352 * MiB;
constexpr size_t WS_PROJ = 384 * MiB;
constexpr size_t WS_MIX = 480 * MiB;
constexpr size_t WS_Z = 512 * MiB;
constexpr size_t WS_H1 = 576 * MiB;
constexpr size_t WS_QP = 640 * MiB;
constexpr size_t WS_IDX = 704 * MiB;
constexpr size_t WS_GATE = 712 * MiB;
constexpr size_t WS_END = 720 * MiB;
constexpr int CW_BAR = 4096;

constexpr int RING_BYTES = 131072;
constexpr int LDSCTL_OFF = RING_BYTES, MISC_OFF = LDSCTL_OFF + 320;
constexpr int LDS_BYTES = 147456;

__device__ __forceinline__ unsigned cvtpk(float lo, float hi) { f32x2_t v = {lo, hi}; bf16x2_t b = __builtin_convertvector(v, bf16x2_t); return __builtin_bit_cast(unsigned, b); }
__device__ __forceinline__ float bf_lo(unsigned w) { return __builtin_bit_cast(float, w << 16); }
__device__ __forceinline__ float bf_hi(unsigned w) { return __builtin_bit_cast(float, w & 0xffff0000u); }
__device__ __forceinline__ float wave_sum(float v) {
#pragma unroll
    for (int o = 1; o < 64; o <<= 1) v += __shfl_xor(v, o);
    return v;
}
__device__ __forceinline__ int crow(int r, int hi) { return (r & 3) + 8 * (r >> 2) + 4 * hi; }

namespace pg8 {
struct EpiProj {
    static constexpr bool PERM = true, AFTER_DRAIN = false;
    bf16_t* O; float qs;
    __device__ __forceinline__ void operator()(const f32x4 (&acc)[2][2][4][2], const Unit& u, int wr, int wc, int fr, int fq) const {
        const int row0 = u.pm * BM + wr * 64 + fr, col0 = u.pn * BM + wc * 32 + 8 * fq, reg = u.pn >> 1;
        const float sc = (reg == 0 || reg == 3) ? qs : 1.0f;
#pragma unroll
        for (int ai = 0; ai < 2; ++ai)
#pragma unroll
            for (int m = 0; m < 4; ++m) { bf16_t* rowp = O + (size_t)(row0 + ai * HALF + m * 16) * 3072 + col0;
#pragma unroll
                for (int bj = 0; bj < 2; ++bj) { const f32x4 v0 = acc[ai][bj][m][0] * sc, v1 = acc[ai][bj][m][1] * sc;
                    u32x4 w; w.x = cvt_pk_bf16(v0[0], v0[1]); w.y = cvt_pk_bf16(v0[2], v0[3]); w.z = cvt_pk_bf16(v1[0], v1[1]); w.w = cvt_pk_bf16(v1[2], v1[3]);
                    *(u32x4*)(rowp + bj * HALF) = w; } }
    }
};
struct EpiResid {
    static constexpr bool PERM = false, AFTER_DRAIN = false;
    const float* base; float* out; float alpha;
    __device__ __forceinline__ void operator()(const f32x4 (&acc)[2][2][4][2], const Unit& u, int wr, int wc, int fr, int fq) const {
        const int col0 = u.pn * BM + wc * 32 + 4 * fq;
#pragma unroll
        for (int ai = 0; ai < 2; ++ai)
#pragma unroll
            for (int m = 0; m < 4; ++m) { const size_t off = (size_t)(u.pm * BM + ai * HALF + wr * 64 + m * 16 + fr) * 1024 + col0;
#pragma unroll
                for (int bj = 0; bj < 2; ++bj)
#pragma unroll
                    for (int n = 0; n < 2; ++n) { const f32x4 bs = *(const f32x4*)(base + off + bj * HALF + n * 16);
                        *(f32x4*)(out + off + bj * HALF + n * 16) = bs * alpha + acc[ai][bj][m][n]; } }
    }
};
}

__device__ __forceinline__ void p0_transpose_item(const float* W, int K, int N, bf16* WT, LAS float* scr, int item, int lane) {
    const int nblk = N / 32, kb = item / nblk, nb = item % nblk, k0 = 64 * kb, n0 = 32 * nb;
#pragma unroll 8
    for (int i = 0; i < 32; ++i) { const int kk = 2 * i + (lane >> 5); scr[kk * 33 + (lane & 31)] = W[(size_t)(k0 + kk) * N + n0 + (lane & 31)]; }
    LDS_WAIT(); asm volatile("" ::: "memory");
    const int c = lane & 7;
#pragma unroll
    for (int j = 0; j < 4; ++j) { const int n = (lane >> 3) + 8 * j; const LAS float* s = scr + (8 * c) * 33 + n;
        v4u o; o.x = cvtpk(s[0 * 33], s[1 * 33]); o.y = cvtpk(s[2 * 33], s[3 * 33]); o.z = cvtpk(s[4 * 33], s[5 * 33]); o.w = cvtpk(s[6 * 33], s[7 * 33]);
        *(GAS v4u*)(WT + (size_t)(n0 + n) * K + k0 + 8 * c) = o; }
    LDS_WAIT(); asm volatile("" ::: "memory");
}
__device__ __forceinline__ void cvt_stream(const float* src, bf16* dst, size_t n8, size_t gtid, size_t gthreads) {
    for (size_t c = gtid; c < n8; c += gthreads) {
        const f32x4 a = ((const GAS f32x4*)src)[2 * c], b = ((const GAS f32x4*)src)[2 * c + 1];
        v4u o; o.x = cvtpk(a.x, a.y); o.y = cvtpk(a.z, a.w); o.z = cvtpk(b.x, b.y); o.w = cvtpk(b.z, b.w);
        ((GAS v4u*)dst)[c] = o;
    }
}

struct Args { const float* in[16]; float* out; unsigned char* ws; int ph_lo, ph_hi, rep_mask, pad; };
typedef const __attribute__((address_space(4))) Args* ArgP;
__device__ __forceinline__ ArgP arg_ptr() { ArgP p = (ArgP)__builtin_amdgcn_kernarg_segment_ptr(); asm volatile("" : "+s"(p)); return p; }

__device__ __forceinline__ void phase_prologue(ArgP a, LAS unsigned char* lds, int vcu, int G) {
    const int tid = opaque_tid(), lane = tid & 63, wave = __builtin_amdgcn_readfirstlane(tid >> 6);
    unsigned char* ws = a->ws;
    LAS float* scr = (LAS float*)(lds + wave * 16384);
    const int gw = vcu * NWAVES + wave, NGW = G * NWAVES;
    constexpr int I_IN = (DM / 64) * (INW / 32), I_O = (DM / 64) * (DM / 32), I_Q = (DM / 64) * (QW / 32), I_L = I_IN + I_O + I_Q;
    for (int it = gw; it < DEPTH * I_L; it += NGW) {
        const int l = it / I_L; int r = it % I_L;
        if (r < I_IN) { p0_transpose_item(a->in[1] + (size_t)l * DM * INW, DM, INW, (bf16*)(ws + WS_WIN) + (size_t)l * INW * DM, scr, r, lane); continue; } r -= I_IN;
        if (r < I_O) { p0_transpose_item(a->in[7] + (size_t)l * DM * DM, DM, DM, (bf16*)(ws + WS_WO) + (size_t)l * DM * DM, scr, r, lane); continue; } r -= I_O;
        p0_transpose_item(a->in[10] + (size_t)l * DM * QW, DM, QW, (bf16*)(ws + WS_WQ) + (size_t)l * QW * DM, scr, r, lane);
    }
    const size_t gtid = (size_t)vcu * NTHR + tid, gthreads = (size_t)G * NTHR;
    cvt_stream(a->in[0], (bf16*)(ws + WS_HB), (size_t)M * DM / 8, gtid, gthreads);
    cvt_stream(a->in[11], (bf16*)(ws + WS_SK), (size_t)DEPTH * 8 * 2 * 128 * 128 / 8, gtid, gthreads);
    for (int row = gw; row < 2 * DEPTH * NEXP; row += NGW) {
        const int tbl = row >= DEPTH * NEXP, r = row - tbl * DEPTH * NEXP;
        const GAS f32x4* src = (const GAS f32x4*)((tbl ? a->in[13] : a->in[12]) + (size_t)r * DM) + lane;
        f32x4 v[4]; float am = 0.f;
#pragma unroll
        for (int j = 0; j < 4; ++j) { v[j] = src[64 * j]; am = fmaxf(am, fmaxf(fmaxf(fabsf(v[j].x), fabsf(v[j].y)), fmaxf(fabsf(v[j].z), fabsf(v[j].w)))); }
#pragma unroll
        for (int o = 1; o < 64; o <<= 1) am = fmaxf(am, __shfl_xor(am, o));
        const float sc = am > 0.f ? 6.0f / am : 1.0f, inv = am > 0.f ? am * (1.0f / 6.0f) : 1.0f;
        GAS unsigned short* dst = (GAS unsigned short*)(ws + (tbl ? WS_EV : WS_EU) + (size_t)r * (DM / 2)) + lane;
#pragma unroll
        for (int j = 0; j < 4; ++j) { unsigned p = __builtin_amdgcn_cvt_scalef32_pk_fp4_f32(0u, v[j].x * sc, v[j].y * sc, 1.0f, 0); p = __builtin_amdgcn_cvt_scalef32_pk_fp4_f32(p, v[j].z * sc, v[j].w * sc, 1.0f, 1); dst[64 * j] = (unsigned short)p; }
        if (lane == 0) ((float*)(ws + (tbl ? WS_VSC : WS_USC)))[r] = inv;
    }
}

__device__ __forceinline__ void phase_ln1(const float* Z, const float* g, const float* b, float* H1, bf16* H1B, int vcu, int G) {
    const int tid = opaque_tid(), lane = tid & 63, wave = __builtin_amdgcn_readfirstlane(tid >> 6);
    const int gw = vcu * NWAVES + wave, NGW = G * NWAVES;
    f32x4 gv[4], bv[4];
#pragma unroll
    for (int j = 0; j < 4; ++j) { gv[j] = ((const GAS f32x4*)g)[lane + 64 * j]; bv[j] = ((const GAS f32x4*)b)[lane + 64 * j]; }
    for (int m = gw; m < M; m += NGW) {
        const GAS f32x4* xr = (const GAS f32x4*)(Z + (size_t)m * DM) + lane;
        f32x4 v[4]; float s = 0.f;
#pragma unroll
        for (int j = 0; j < 4; ++j) { v[j] = xr[64 * j]; s += (v[j].x + v[j].y) + (v[j].z + v[j].w); }
        const float mean = wave_sum(s) * (1.f / DM); float s2 = 0.f;
#pragma unroll
        for (int j = 0; j < 4; ++j) { v[j] = v[j] - mean; s2 += (v[j].x * v[j].x + v[j].y * v[j].y) + (v[j].z * v[j].z + v[j].w * v[j].w); }
        const float rstd = 1.f / sqrtf(wave_sum(s2) * (1.f / DM) + LN_EPS);
        GAS f32x4* o4 = (GAS f32x4*)(H1 + (size_t)m * DM) + lane;
        GAS v2u* o2 = (GAS v2u*)(H1B + (size_t)m * DM) + lane;
#pragma unroll
        for (int j = 0; j < 4; ++j) { const f32x4 y = v[j] * rstd * gv[j] + bv[j]; o4[64 * j] = y; v2u w; w.x = cvtpk(y.x, y.y); w.y = cvtpk(y.z, y.w); o2[64 * j] = w; }
    }
}

namespace att {
typedef short v4i16_t __attribute__((ext_vector_type(4)));
constexpr int KP = 144;
constexpr int D_V = 2 * 64 * KP, D_BUF = D_V + 16384;
constexpr int S_V = 64 * KP, S_BUF = S_V + 8192;
constexpr float SB_DONE = 64.0f;
__device__ __forceinline__ s16x4 vtr(const LAS unsigned char* p) { return __builtin_bit_cast(s16x4, __builtin_amdgcn_ds_read_tr16_b64_v4i16((LAS v4i16_t*)p)); }
__device__ __forceinline__ float swapsum(float v) { auto rr = __builtin_amdgcn_permlane32_swap(__float_as_uint(v), __float_as_uint(v), false, false); return __uint_as_float(rr[0]) + __uint_as_float(rr[1]); }
__device__ __forceinline__ float swapmax(float v) { auto rr = __builtin_amdgcn_permlane32_swap(__float_as_uint(v), __float_as_uint(v), false, false); return fmaxf(__uint_as_float(rr[0]), __uint_as_float(rr[1])); }
#define ATT_MFMA(a, b, c) __builtin_amdgcn_mfma_f32_32x32x16_bf16((a), (b), (c), 0, 0, 0)
#define ATT_PF(S, s) (bf16x8)__builtin_bit_cast(bf16x8, ((v4u){cvtpk(S[8 * (s)], S[8 * (s) + 1]), cvtpk(S[8 * (s) + 2], S[8 * (s) + 3]), cvtpk(S[8 * (s) + 4], S[8 * (s) + 5]), cvtpk(S[8 * (s) + 6], S[8 * (s) + 7])}))

__device__ __forceinline__ void diff_unit(LAS unsigned char* lds, const bf16* proj, bf16* mix, int b, int h, int qt, float lam, float sl2, const float* subg, float gscale) {
    const int tid = opaque_tid(), lane = tid & 63, r32 = lane & 31, hi = lane >> 5;
    const int wid = __builtin_amdgcn_readfirstlane(tid >> 6), mp = wid >> 2, qs = wid & 3;
    const size_t rowbase = (size_t)b * SEQ;
    const int tq = 128 * qt + 32 * qs + r32;
    bf16x8 qf[4];
    { const bf16* Qp = proj + (rowbase + tq) * INW + h * 128 + mp * 64 + 8 * hi;
#pragma unroll
      for (int s = 0; s < 4; ++s) qf[s] = *(const GAS bf16x8*)(Qp + 16 * s); }
    const int krow = tid >> 3, kch = tid & 7, vrow = tid >> 4, vch = tid & 15;
    const bf16* ksrc = proj + (rowbase + krow) * INW + 512 + h * 128 + kch * 8;
    const bf16* vsrc = proj + (rowbase + vrow) * INW + 1024 + h * 128 + vch * 8;
    const int kdst = krow * KP + kch * 16;
    const int vdst = ((vrow >> 3) * 4 + (vch >> 2)) * 512 + (vrow & 7) * 64 + (vch & 3) * 16;
    const int NT = 2 * qt + 2;
    v4u sk1, sk2, sv0, sv1;
#define DLOAD(kt) do { const size_t o_ = (size_t)(kt) * 64 * INW; sk1 = *(const GAS v4u*)(ksrc + o_); sk2 = *(const GAS v4u*)(ksrc + o_ + 64); \
        sv0 = *(const GAS v4u*)(vsrc + o_); sv1 = *(const GAS v4u*)(vsrc + o_ + (size_t)32 * INW); } while (0)
#define DWRITE(buf) do { LAS unsigned char* p_ = lds + (buf) * D_BUF; *(LAS v4u*)(p_ + kdst) = sk1; *(LAS v4u*)(p_ + 64 * KP + kdst) = sk2; \
        *(LAS v4u*)(p_ + D_V + vdst) = sv0; *(LAS v4u*)(p_ + D_V + 8192 + vdst) = sv1; } while (0)
    DLOAD(NT - 1); DWRITE(0); __syncthreads();
    float mhat = -1e30f, lsum = 0.f;
    f32x16 O[4];
#pragma unroll
    for (int d = 0; d < 4; ++d) O[d] = (f32x16){};
    for (int it = 0; it < NT; ++it) {
        const int kt = NT - 1 - it, cur = it & 1;
        if (it + 1 < NT) DLOAD(kt - 1);
        if (!(kt == NT - 1 && qs < 2)) {
            const LAS unsigned char* Kb = lds + cur * D_BUF + mp * (64 * KP) + r32 * KP + hi * 16;
            const LAS unsigned char* Vb = lds + cur * D_BUF + D_V + (4 * hi + ((lane & 15) >> 2)) * 64 + ((lane >> 4) & 1) * 32 + (lane & 3) * 8;
            f32x16 S0, S1;
            const float base0 = -sl2 * (float)(tq - 64 * kt - 4 * hi);
#pragma unroll
            for (int r = 0; r < 16; ++r) { const float c = (float)((r & 3) + 8 * (r >> 2)); S0[r] = fmaf(sl2, c, base0); S1[r] = fmaf(sl2, c + 32.f, base0); }
            bf16x8 ka[8];
#pragma unroll
            for (int s = 0; s < 4; ++s) { ka[2 * s] = *(const LAS bf16x8*)(Kb + s * 32); ka[2 * s + 1] = *(const LAS bf16x8*)(Kb + 32 * KP + s * 32); }
#pragma unroll
            for (int s = 0; s < 4; ++s) { S0 = ATT_MFMA(ka[2 * s], qf[s], S0); S1 = ATT_MFMA(ka[2 * s + 1], qf[s], S1); }
            s16x4 vlo[8], vup[8];
#pragma unroll
            for (int d = 0; d < 2; ++d)
#pragma unroll
                for (int ks = 0; ks < 4; ++ks) { vlo[d * 4 + ks] = vtr(Vb + ((2 * ks) * 4 + d) * 512); vup[d * 4 + ks] = vtr(Vb + ((2 * ks + 1) * 4 + d) * 512); }
            __builtin_amdgcn_sched_barrier(0);
            if (kt >= NT - 2) {
                const int kb = 64 * kt + 4 * hi;
#pragma unroll
                for (int r = 0; r < 16; ++r) { const int kv = kb + (r & 3) + 8 * (r >> 2); if (kv > tq) S0[r] = -INFINITY; if (kv + 32 > tq) S1[r] = -INFINITY; }
            }
            float rm = fmaxf(S0[0], S1[0]);
#pragma unroll
            for (int r = 1; r < 16; ++r) rm = fmaxf(rm, fmaxf(S0[r], S1[r]));
            rm = swapmax(rm);
            if (__any(rm > mhat)) {
                const float mnew = fmaxf(mhat, rm), f = __builtin_amdgcn_exp2f(mhat - mnew);
                mhat = mnew; lsum *= f;
#pragma unroll
                for (int d = 0; d < 4; ++d)
#pragma unroll
                    for (int r = 0; r < 16; ++r) O[d][r] *= f;
            }
            float ps = 0.f;
#pragma unroll
            for (int r = 0; r < 16; ++r) { S0[r] = __builtin_amdgcn_exp2f(S0[r] - mhat); S1[r] = __builtin_amdgcn_exp2f(S1[r] - mhat); ps += S0[r] + S1[r]; }
            lsum += ps;
            bf16x8 pf[4];
            pf[0] = ATT_PF(S0, 0); pf[1] = ATT_PF(S0, 1); pf[2] = ATT_PF(S1, 0); pf[3] = ATT_PF(S1, 1);
#pragma unroll
            for (int d = 0; d < 2; ++d)
#pragma unroll
                for (int ks = 0; ks < 4; ++ks) { const s16x4 lo = vlo[d * 4 + ks], up = vup[d * 4 + ks];
                    const bf16x8 vf = (bf16x8){lo[0], lo[1], lo[2], lo[3], up[0], up[1], up[2], up[3]};
                    O[d] = ATT_MFMA(vf, pf[ks], O[d]); }
#pragma unroll
            for (int d = 2; d < 4; ++d)
#pragma unroll
                for (int ks = 0; ks < 4; ++ks) { const s16x4 lo = vtr(Vb + ((2 * ks) * 4 + d) * 512), up = vtr(Vb + ((2 * ks + 1) * 4 + d) * 512);
                    const bf16x8 vf = (bf16x8){lo[0], lo[1], lo[2], lo[3], up[0], up[1], up[2], up[3]};
                    O[d] = ATT_MFMA(vf, pf[ks], O[d]); }
        }
        if (it + 1 < NT) DWRITE(cur ^ 1);
        __syncthreads();
    }
#undef DLOAD
#undef DWRITE
    lsum = swapsum(lsum);
    const float inv = 1.0f / lsum;
    LAS float* X = (LAS float*)lds;
    if (mp == 1) {
#pragma unroll
        for (int d = 0; d < 4; ++d)
#pragma unroll
            for (int r = 0; r < 16; ++r) X[(qs * 64 + d * 16 + r) * 64 + lane] = O[d][r] * inv;
    }
    __syncthreads();
    if (mp == 0) {
        float ss = 0.f;
#pragma unroll
        for (int d = 0; d < 4; ++d)
#pragma unroll
            for (int r = 0; r < 16; ++r) { const float v = O[d][r] * inv - lam * X[(qs * 64 + d * 16 + r) * 64 + lane]; O[d][r] = v; ss += v * v; }
        ss = swapsum(ss);
        const float rs = gscale / sqrtf(ss * (1.0f / 128.0f) + RMS_EPS);
        bf16* op = mix + (rowbase + tq) * DM + h * 128 + 4 * hi;
#pragma unroll
        for (int d = 0; d < 4; ++d)
#pragma unroll
            for (int g = 0; g < 4; ++g) { const int dv0 = 32 * d + 8 * g; const f32x4 gv = *(const GAS f32x4*)(subg + dv0 + 4 * hi);
                v2u w; w.x = cvtpk(O[d][4 * g] * rs * gv.x, O[d][4 * g + 1] * rs * gv.y); w.y = cvtpk(O[d][4 * g + 2] * rs * gv.z, O[d][4 * g + 3] * rs * gv.w);
                *(GAS v2u*)(op + dv0) = w; }
    }
    __syncthreads();
}

__device__ __forceinline__ void sb_unit(LAS unsigned char* lds, const bf16* proj, bf16* mix, int b, int g, int qt) {
    const int tid = opaque_tid(), lane = tid & 63, r32 = lane & 31, hi = lane >> 5;
    const int wid = __builtin_amdgcn_readfirstlane(tid >> 6);
    const size_t rowbase = (size_t)b * SEQ;
    const int tq = 256 * qt + 32 * wid + r32;
    bf16x8 qf[4];
    { const bf16* Qp = proj + (rowbase + tq) * INW + 1536 + g * 64 + 8 * hi;
#pragma unroll
      for (int s = 0; s < 4; ++s) qf[s] = *(const GAS bf16x8*)(Qp + 16 * s); }
    const int krow = tid >> 3, kch = tid & 7;
    const bf16* ksrc = proj + (rowbase + krow) * INW + 2048 + g * 64 + kch * 8;
    const bf16* vsrc = proj + (rowbase + krow) * INW + 2560 + g * 64 + kch * 8;
    const int kdst = krow * KP + kch * 16;
    const int vdst = ((krow >> 3) * 2 + (kch >> 2)) * 512 + (krow & 7) * 64 + (kch & 3) * 16;
    const int NT = 4 * qt + 4, ktw = 4 * qt + (wid >> 1);
    v4u sk, sv;
#define SLOAD(kt) do { const size_t o_ = (size_t)(kt) * 64 * INW; sk = *(const GAS v4u*)(ksrc + o_); sv = *(const GAS v4u*)(vsrc + o_); } while (0)
#define SWRITE(buf) do { LAS unsigned char* p_ = lds + (buf) * S_BUF; *(LAS v4u*)(p_ + kdst) = sk; *(LAS v4u*)(p_ + S_V + vdst) = sv; } while (0)
    SLOAD(NT - 1); SWRITE(0);
    LAS unsigned* dflag = (LAS unsigned*)(lds + 2 * S_BUF);
    if (tid < 16) dflag[tid] = 0u;
    __syncthreads();
    float c2 = 0.f;
    f32x16 O[2];
    O[0] = (f32x16){}; O[1] = (f32x16){};
    for (int i = 0; i < NT; ++i) {
        const int kt = NT - 1 - i, cur = i & 1;
        if (i > 0) { unsigned alld = 1u;
#pragma unroll
            for (int w = 0; w < 8; ++w) alld &= dflag[(cur ^ 1) * 8 + w];
            if (alld) break; }
        if (i + 1 < NT) SLOAD(kt - 1);
        if (kt <= ktw) {
            const LAS unsigned char* Kb = lds + cur * S_BUF + r32 * KP + hi * 16;
            const LAS unsigned char* Vb = lds + cur * S_BUF + S_V + (4 * hi + ((lane & 15) >> 2)) * 64 + ((lane >> 4) & 1) * 32 + (lane & 3) * 8;
            f32x16 S0 = (f32x16){}, S1 = (f32x16){};
            bf16x8 ka[8];
#pragma unroll
            for (int s = 0; s < 4; ++s) { ka[2 * s] = *(const LAS bf16x8*)(Kb + s * 32); ka[2 * s + 1] = *(const LAS bf16x8*)(Kb + 32 * KP + s * 32); }
#pragma unroll
            for (int s = 0; s < 4; ++s) { S0 = ATT_MFMA(ka[2 * s], qf[s], S0); S1 = ATT_MFMA(ka[2 * s + 1], qf[s], S1); }
            s16x4 vlo[8], vup[8];
#pragma unroll
            for (int d = 0; d < 2; ++d)
#pragma unroll
                for (int ks = 0; ks < 4; ++ks) { vlo[d * 4 + ks] = vtr(Vb + ((2 * ks) * 2 + d) * 512); vup[d * 4 + ks] = vtr(Vb + ((2 * ks + 1) * 2 + d) * 512); }
            __builtin_amdgcn_sched_barrier(0);
            const bool diag = (kt == ktw);
            const int kb = 64 * kt + 4 * hi;
            f32x16 x0, x1;
#pragma unroll
            for (int r = 0; r < 16; ++r) { x0[r] = -__builtin_amdgcn_logf(1.0f + __builtin_amdgcn_exp2f(S0[r])); x1[r] = -__builtin_amdgcn_logf(1.0f + __builtin_amdgcn_exp2f(S1[r])); }
            if (diag) {
#pragma unroll
                for (int r = 0; r < 16; ++r) { const int kv = kb + (r & 3) + 8 * (r >> 2); if (kv >= tq) x0[r] = 0.f; if (kv + 32 >= tq) x1[r] = 0.f; }
            }
#pragma unroll
            for (int gq = 0; gq < 4; ++gq) { const int i4 = 4 * gq;
                x0[i4 + 2] += x0[i4 + 3]; x0[i4 + 1] += x0[i4 + 2]; x0[i4] += x0[i4 + 1];
                x1[i4 + 2] += x1[i4 + 3]; x1[i4 + 1] += x1[i4 + 2]; x1[i4] += x1[i4 + 1]; }
            float run = c2;
#pragma unroll
            for (int gq = 3; gq >= 0; --gq) { auto rr = __builtin_amdgcn_permlane32_swap(__float_as_uint(x1[4 * gq]), __float_as_uint(x1[4 * gq]), false, false);
                const float lo = __uint_as_float(rr[0]), up = __uint_as_float(rr[1]); const float off = run + (hi == 0 ? up : 0.f); run += lo + up;
                x1[4 * gq] += off; x1[4 * gq + 1] += off; x1[4 * gq + 2] += off; x1[4 * gq + 3] += off; }
#pragma unroll
            for (int gq = 3; gq >= 0; --gq) { auto rr = __builtin_amdgcn_permlane32_swap(__float_as_uint(x0[4 * gq]), __float_as_uint(x0[4 * gq]), false, false);
                const float lo = __uint_as_float(rr[0]), up = __uint_as_float(rr[1]); const float off = run + (hi == 0 ? up : 0.f); run += lo + up;
                x0[4 * gq] += off; x0[4 * gq + 1] += off; x0[4 * gq + 2] += off; x0[4 * gq + 3] += off; }
            c2 = run;
#pragma unroll
            for (int r = 0; r < 16; ++r) { S0[r] = __builtin_amdgcn_exp2f(S0[r] + x0[r]); S1[r] = __builtin_amdgcn_exp2f(S1[r] + x1[r]); }
            if (diag) {
#pragma unroll
                for (int r = 0; r < 16; ++r) { const int kv = kb + (r & 3) + 8 * (r >> 2); if (kv >= tq) S0[r] = 0.f; if (kv + 32 >= tq) S1[r] = 0.f; }
            }
            bf16x8 pf[4];
            pf[0] = ATT_PF(S0, 0); pf[1] = ATT_PF(S0, 1); pf[2] = ATT_PF(S1, 0); pf[3] = ATT_PF(S1, 1);
#pragma unroll
            for (int d = 0; d < 2; ++d)
#pragma unroll
                for (int ks = 0; ks < 4; ++ks) { const s16x4 lo = vlo[d * 4 + ks], up = vup[d * 4 + ks];
                    const bf16x8 vf = (bf16x8){lo[0], lo[1], lo[2], lo[3], up[0], up[1], up[2], up[3]};
                    O[d] = ATT_MFMA(vf, pf[ks], O[d]); }
        }
        if (lane == 0) dflag[cur * 8 + wid] = (kt <= ktw && __all(c2 < -SB_DONE)) ? 1u : 0u;
        if (i + 1 < NT) SWRITE(cur ^ 1);
        __syncthreads();
    }
    __syncthreads();
#undef SLOAD
#undef SWRITE
    bf16* op = mix + (rowbase + tq) * DM + 512 + g * 64 + 4 * hi;
#pragma unroll
    for (int d = 0; d < 2; ++d)
#pragma unroll
        for (int gq = 0; gq < 4; ++gq) { v2u w; w.x = cvtpk(O[d][4 * gq], O[d][4 * gq + 1]); w.y = cvtpk(O[d][4 * gq + 2], O[d][4 * gq + 3]);
            *(GAS v2u*)(op + 32 * d + 8 * gq) = w; }
}
#undef ATT_MFMA
#undef ATT_PF
}

__device__ __forceinline__ void phase_attention(ArgP a, int layer, LAS unsigned char* lds, int vcu) {
    const int repmask = a->rep_mask;
    const int lane = opaque_tid() & 63;
    const bf16* proj = (const bf16*)(a->ws + WS_PROJ); bf16* mix = (bf16*)(a->ws + WS_MIX);
    const float linit = 0.8f - 0.6f * expf(-0.3f * (float)layer);
    const float d1 = wave_sum(a->in[2][layer * 64 + lane] * a->in[3][layer * 64 + lane]);
    const float d2 = wave_sum(a->in[4][layer * 64 + lane] * a->in[5][layer * 64 + lane]);
    const float lam = expf(d1) - expf(d2) + linit;
    const float* subg = a->in[6] + layer * 128;
    {
        const int bh = vcu >> 3, s = vcu & 7, b = bh >> 2, h = bh & 3;
        const float sl2 = exp2f(-2.0f * (float)(h + 1)) * LOG2E;
#pragma nounroll
        for (int i = 0; i < 2 + 2 * ((repmask >> 8) & 1); ++i) att::diff_unit(lds, proj, mix, b, h, (i & 1) ? s : 15 - s, lam, sl2, subg, 1.0f - linit);
    }
    {
        const int bg = vcu >> 2, s = vcu & 3, b = bg >> 3, g = bg & 7;
#pragma nounroll
        for (int i = 0; i < 2 + 2 * ((repmask >> 9) & 1); ++i) att::sb_unit(lds, proj, mix, b, g, (i & 1) ? s : 7 - s);
    }
}

namespace peer {
constexpr int SKP = 272;
constexpr int L_CAND = 2 * 128 * SKP;
__device__ __forceinline__ unsigned f2mono(float f) { const unsigned u = __float_as_uint(f); return u ^ ((unsigned)((int)u >> 31) | 0x80000000u); }
__device__ __forceinline__ float mono2f(unsigned m) { const unsigned u = (m & 0x80000000u) ? (m ^ 0x80000000u) : ~m; return __uint_as_float(u); }
__device__ __forceinline__ float key_score(unsigned k) { return mono2f((k & ~127u) | 64u); }
__device__ __forceinline__ void sort16_desc(unsigned (&v)[16]) {
#pragma unroll
    for (int k = 2; k <= 16; k <<= 1)
#pragma unroll
        for (int j = k >> 1; j > 0; j >>= 1)
#pragma unroll
            for (int i = 0; i < 16; ++i) { const int p = i ^ j; if (p > i) { const bool desc = ((i & k) == 0); const unsigned a = v[i], b = v[p];
                const unsigned mx = a > b ? a : b, mn = a > b ? b : a; v[i] = desc ? mx : mn; v[p] = desc ? mn : mx; } }
}
__device__ __forceinline__ void merge16_desc(unsigned (&a)[16], const unsigned (&b)[16]) {
#pragma unroll
    for (int i = 0; i < 16; ++i) a[i] = a[i] > b[15 - i] ? a[i] : b[15 - i];
#pragma unroll
    for (int j = 8; j > 0; j >>= 1)
#pragma unroll
        for (int i = 0; i < 16; ++i) { const int p = i ^ j; if (p > i) { const unsigned x = a[i], y = a[p]; a[i] = x > y ? x : y; a[p] = x > y ? y : x; } }
}
__device__ __forceinline__ void score_unit(LAS unsigned char* lds, const bf16* qp, const bf16* skl, int* idxo, float* gateo, int tile, int h) {
    const int tid = opaque_tid(), lane = tid & 63, r32 = lane & 31, hi = lane >> 5;
    const int wid = __builtin_amdgcn_readfirstlane(tid >> 6), p = wid >> 2, tg = wid & 3;
#pragma unroll
    for (int j = 0; j < 8; ++j) { const int c = tid + 512 * j, row = c >> 4, ch = c & 15;
        *(LAS v4u*)(lds + row * SKP + ch * 16) = *(const GAS v4u*)(skl + ((size_t)h * 256 + row) * 128 + ch * 8); }
    bf16x8 qf[8];
    { const bf16* Qp = qp + (size_t)(tile * 128 + tg * 32 + r32) * QW + h * 256 + p * 128 + 8 * hi;
#pragma unroll
      for (int s = 0; s < 8; ++s) qf[s] = *(const GAS bf16x8*)(Qp + 16 * s); }
    __syncthreads();
    unsigned v[4][16];
#pragma unroll
    for (int blk = 0; blk < 4; ++blk) {
        f32x16 S = (f32x16){};
        const LAS unsigned char* kb = lds + (p * 128 + blk * 32 + r32) * SKP + hi * 16;
#pragma unroll
        for (int s = 0; s < 8; ++s) S = __builtin_amdgcn_mfma_f32_32x32x16_bf16(*(const LAS bf16x8*)(kb + s * 32), qf[s], S, 0, 0, 0);
#pragma unroll
        for (int r = 0; r < 16; ++r) v[blk][r] = (f2mono(S[r]) & ~127u) | (unsigned)(127 - (32 * blk + (r & 3) + 8 * (r >> 2)) - 4 * hi);
    }
    sort16_desc(v[0]); sort16_desc(v[1]); sort16_desc(v[2]); sort16_desc(v[3]);
    merge16_desc(v[0], v[1]); merge16_desc(v[2], v[3]); merge16_desc(v[0], v[2]);
    unsigned lo[16], up[16];
#pragma unroll
    for (int i = 0; i < 16; ++i) { auto rr = __builtin_amdgcn_permlane32_swap(v[0][i], v[0][i], false, false); lo[i] = rr[0]; up[i] = rr[1]; }
    merge16_desc(lo, up);
    LAS unsigned* cand = (LAS unsigned*)(lds + L_CAND);
    if (hi == 0) { LAS v4u* cp = (LAS v4u*)(cand + ((tg * 32 + r32) * 2 + p) * 16);
#pragma unroll
        for (int i = 0; i < 4; ++i) cp[i] = (v4u){lo[4 * i], lo[4 * i + 1], lo[4 * i + 2], lo[4 * i + 3]}; }
    __syncthreads();
    if (tid < 128) {
        const LAS unsigned* c1 = cand + (tid * 2) * 16; const LAS unsigned* c2 = c1 + 16;
        float s1[16], s2[16];
#pragma unroll
        for (int i = 0; i < 16; ++i) { s1[i] = key_score(c1[i]); s2[i] = key_score(c2[i]); }
        unsigned w[4][16];
#pragma unroll
        for (int n = 0; n < 64; ++n) w[n >> 4][n & 15] = 0u;
        { int n = 0;
#pragma unroll
          for (int i = 0; i < 16; ++i)
#pragma unroll
              for (int j = 0; j < 16; ++j) if ((i + 1) * (j + 1) <= 16) { w[n >> 4][n & 15] = (f2mono(s1[i] + s2[j]) & ~255u) | (unsigned)(255 - (i * 16 + j)); ++n; } }
        sort16_desc(w[0]); sort16_desc(w[1]); sort16_desc(w[2]); sort16_desc(w[3]);
        merge16_desc(w[0], w[1]); merge16_desc(w[2], w[3]); merge16_desc(w[0], w[2]);
        float sm[16]; int ix[16]; float mx = -1e30f;
#pragma unroll
        for (int k = 0; k < 16; ++k) { const unsigned code = 255u - (w[0][k] & 255u); const unsigned e1 = c1[code >> 4], e2 = c2[code & 15];
            sm[k] = key_score(e1) + key_score(e2); ix[k] = (int)((127u - (e1 & 127u)) * 128u + (127u - (e2 & 127u))); mx = fmaxf(mx, sm[k]); }
        float den = 0.f;
#pragma unroll
        for (int k = 0; k < 16; ++k) { sm[k] = __builtin_amdgcn_exp2f((sm[k] - mx) * LOG2E); den += sm[k]; }
        const float rden = 1.0f / den;
        const size_t o = (size_t)(tile * 128 + tid) * NSEL + h * 16;
#pragma unroll
        for (int i = 0; i < 4; ++i) { *(GAS v4u*)(idxo + o + 4 * i) = (v4u){(unsigned)ix[4 * i], (unsigned)ix[4 * i + 1], (unsigned)ix[4 * i + 2], (unsigned)ix[4 * i + 3]};
            *(GAS f32x4*)(gateo + o + 4 * i) = (f32x4){sm[4 * i] * rden, sm[4 * i + 1] * rden, sm[4 * i + 2] * rden, sm[4 * i + 3] * rden}; }
    }
    __syncthreads();
}
}

__device__ __forceinline__ void phase_score(ArgP a, int layer, LAS unsigned char* lds, int vcu, int G) {
    const bf16* qp = (const bf16*)(a->ws + WS_QP); const bf16* skl = (const bf16*)(a->ws + WS_SK) + (size_t)layer * 8 * 2 * 128 * 128;
#pragma nounroll
    for (int u = vcu * 4; u < vcu * 4 + 4; ++u) peer::score_unit(lds, qp, skl, (int*)(a->ws + WS_IDX), (float*)(a->ws + WS_GATE), u >> 3, u & 7);
    (void)G;
}

__device__ __forceinline__ float gelu_erf(float x) { return 0.5f * x * (1.0f + erff(x * 0.70710678118654752f)); }
constexpr int ROWB = DM / 2;
struct GBatch { v2u u[16], v[16]; float su, sv, g; };
__device__ __forceinline__ void gather_load(GBatch& B, __amdgpu_buffer_rsrc_t ru, __amdgpu_buffer_rsrc_t rv, const float* USC, const float* VSC, int ireg, float greg, int l0, int lane) {
    const unsigned loff = (unsigned)lane * 8u;
#pragma unroll
    for (int k = 0; k < 16; ++k) { const unsigned eo = (unsigned)__builtin_amdgcn_readlane(ireg, l0 + k) * (unsigned)ROWB;
        B.u[k] = __builtin_bit_cast(v2u, __builtin_amdgcn_raw_buffer_load_b64(ru, loff, eo, 0)); B.v[k] = __builtin_bit_cast(v2u, __builtin_amdgcn_raw_buffer_load_b64(rv, loff, eo, 0)); }
    const int el = __shfl(ireg, l0 + (lane >> 2));
    B.su = USC[el]; B.sv = VSC[el]; B.g = __shfl(greg, l0 + (lane >> 2));
}
__device__ __forceinline__ void fp4_dec8(unsigned w, f32x2_t (&o)[4]) { o[0] = __builtin_amdgcn_cvt_scalef32_pk_f32_fp4(w, 1.0f, 0); o[1] = __builtin_amdgcn_cvt_scalef32_pk_f32_fp4(w, 1.0f, 1); o[2] = __builtin_amdgcn_cvt_scalef32_pk_f32_fp4(w, 1.0f, 2); o[3] = __builtin_amdgcn_cvt_scalef32_pk_f32_fp4(w, 1.0f, 3); }
__device__ __forceinline__ void gather_compute(const GBatch& B, const f32x2_t (&xp)[8], f32x2_t (&y)[8], int lane) {
    float d[16];
#pragma unroll
    for (int k = 0; k < 16; ++k) { f32x2_t acc = {0.f, 0.f};
#pragma unroll
        for (int i = 0; i < 2; ++i) { f32x2_t q[4]; fp4_dec8(B.u[k][i], q);
#pragma unroll
            for (int b = 0; b < 4; ++b) acc = q[b] * xp[4 * i + b] + acc; }
        d[k] = acc.x + acc.y; }
    float r8[8], r4[4], r2[2];
#pragma unroll
    for (int j = 0; j < 8; ++j) { auto rr = __builtin_amdgcn_permlane32_swap(__float_as_uint(d[j]), __float_as_uint(d[8 + j]), false, false); r8[j] = __uint_as_float(rr[0]) + __uint_as_float(rr[1]); }
#pragma unroll
    for (int j = 0; j < 4; ++j) { auto rr = __builtin_amdgcn_permlane16_swap(__float_as_uint(r8[j]), __float_as_uint(r8[4 + j]), false, false); r4[j] = __uint_as_float(rr[0]) + __uint_as_float(rr[1]); }
    const bool b3 = (lane >> 3) & 1, b2 = (lane >> 2) & 1;
#pragma unroll
    for (int j = 0; j < 2; ++j) r2[j] = (b3 ? r4[2 + j] : r4[j]) + __shfl_xor(b3 ? r4[j] : r4[2 + j], 8);
    float tot = (b2 ? r2[1] : r2[0]) + __shfl_xor(b2 ? r2[0] : r2[1], 4);
    tot += __shfl_xor(tot, 2); tot += __shfl_xor(tot, 1);
    const float c = B.g * gelu_erf(tot * B.su) * B.sv;
#pragma unroll
    for (int k = 0; k < 16; ++k) { const float ck = __uint_as_float(__builtin_amdgcn_readlane(__float_as_uint(c), 4 * k)); const f32x2_t c2 = {ck, ck};
#pragma unroll
        for (int i = 0; i < 2; ++i) { f32x2_t q[4]; fp4_dec8(B.v[k][i], q);
#pragma unroll
            for (int b = 0; b < 4; ++b) y[4 * i + b] = q[b] * c2 + y[4 * i + b]; } }
}

__device__ __forceinline__ void phase_gather(ArgP a, int layer, int vcu, int G) {
    const int tid = opaque_tid(), lane = tid & 63, wave = __builtin_amdgcn_readfirstlane(tid >> 6);
    const float* H1 = (const float*)(a->ws + WS_H1); const int* IDX = (const int*)(a->ws + WS_IDX); const float* GATE = (const float*)(a->ws + WS_GATE);
    const __amdgpu_buffer_rsrc_t EU = __builtin_amdgcn_make_buffer_rsrc((void*)(a->ws + WS_EU + (size_t)layer * NEXP * ROWB), 0, NEXP * ROWB, 0x00020000);
    const __amdgpu_buffer_rsrc_t EV = __builtin_amdgcn_make_buffer_rsrc((void*)(a->ws + WS_EV + (size_t)layer * NEXP * ROWB), 0, NEXP * ROWB, 0x00020000);
    const float* USC = (const float*)(a->ws + WS_USC) + layer * NEXP; const float* VSC = (const float*)(a->ws + WS_VSC) + layer * NEXP;
    const float* g2 = a->in[14] + layer * DM; const float* b2 = a->in[15] + layer * DM;
    float* Hout = a->out; bf16* HB = (bf16*)(a->ws + WS_HB);
    const int gw = vcu * NWAVES + wave, NGW = G * NWAVES;
    for (int t = gw; t < M; t += NGW) {
        const GAS f32x4* xr = (const GAS f32x4*)(H1 + (size_t)t * DM) + 4 * lane;
        f32x4 xv[4];
#pragma unroll
        for (int q = 0; q < 4; ++q) xv[q] = xr[q];
        f32x2_t xp[8], y[8];
#pragma unroll
        for (int q = 0; q < 4; ++q) { xp[2 * q] = (f32x2_t){xv[q].x, xv[q].y}; xp[2 * q + 1] = (f32x2_t){xv[q].z, xv[q].w}; }
#pragma unroll
        for (int i = 0; i < 8; ++i) y[i] = (f32x2_t){0.f, 0.f};
        const int idx_lo = IDX[(size_t)t * NSEL + lane], idx_hi = IDX[(size_t)t * NSEL + 64 + lane];
        const float gate_lo = GATE[(size_t)t * NSEL + lane], gate_hi = GATE[(size_t)t * NSEL + 64 + lane];
        GBatch A, B;
        gather_load(A, EU, EV, USC, VSC, idx_lo, gate_lo, 0, lane);
#pragma unroll 1
        for (int kb = 0; kb < 8; kb += 2) {
            gather_load(B, EU, EV, USC, VSC, kb < 4 ? idx_lo : idx_hi, kb < 4 ? gate_lo : gate_hi, 16 * ((kb + 1) & 3), lane);
            gather_compute(A, xp, y, lane);
            if (kb + 2 < 8) gather_load(A, EU, EV, USC, VSC, kb + 2 < 4 ? idx_lo : idx_hi, kb + 2 < 4 ? gate_lo : gate_hi, 16 * ((kb + 2) & 3), lane);
            gather_compute(B, xp, y, lane);
        }
        float z[16];
#pragma unroll
        for (int q = 0; q < 4; ++q) { z[4 * q] = ALPHA * xv[q].x + y[2 * q].x; z[4 * q + 1] = ALPHA * xv[q].y + y[2 * q].y; z[4 * q + 2] = ALPHA * xv[q].z + y[2 * q + 1].x; z[4 * q + 3] = ALPHA * xv[q].w + y[2 * q + 1].y; }
        float s = 0.f;
#pragma unroll
        for (int i = 0; i < 16; ++i) s += z[i];
        const float mean = wave_sum(s) * (1.f / DM); float s2 = 0.f;
#pragma unroll
        for (int i = 0; i < 16; ++i) { z[i] -= mean; s2 += z[i] * z[i]; }
        const float rstd = 1.f / sqrtf(wave_sum(s2) * (1.f / DM) + LN_EPS);
        const GAS f32x4* gp = (const GAS f32x4*)g2 + 4 * lane; const GAS f32x4* bp = (const GAS f32x4*)b2 + 4 * lane;
        f32x4 o[4];
#pragma unroll
        for (int q = 0; q < 4; ++q) { const f32x4 gv = gp[q], bv = bp[q];
            o[q] = (f32x4){z[4 * q] * rstd * gv.x + bv.x, z[4 * q + 1] * rstd * gv.y + bv.y, z[4 * q + 2] * rstd * gv.z + bv.z, z[4 * q + 3] * rstd * gv.w + bv.w}; }
        GAS f32x4* op = (GAS f32x4*)(Hout + (size_t)t * DM) + 4 * lane;
#pragma unroll
        for (int q = 0; q < 4; ++q) op[q] = o[q];
        GAS v4u* hp = (GAS v4u*)(HB + (size_t)t * DM) + 2 * lane;
        hp[0] = (v4u){cvtpk(o[0].x, o[0].y), cvtpk(o[0].z, o[0].w), cvtpk(o[1].x, o[1].y), cvtpk(o[1].z, o[1].w)};
        hp[1] = (v4u){cvtpk(o[2].x, o[2].y), cvtpk(o[2].z, o[2].w), cvtpk(o[3].x, o[3].y), cvtpk(o[3].z, o[3].w)};
    }
}

constexpr int PH_PER_LAYER = 7, NPHASE = 1 + DEPTH * PH_PER_LAYER;
#ifndef REPMASK
#define REPMASK 0
#endif
#ifndef PHMASK
#define PHMASK 0xFF
#endif
constexpr int NVCU = 256;

__global__ void __launch_bounds__(NTHR, 2) fwd_kernel(Args args) {
    extern __shared__ __attribute__((aligned(16))) unsigned char lds_raw[];
    LAS unsigned char* lds = (LAS unsigned char*)lds_raw;
    const int tid = threadIdx.x;
    const int G = gridDim.x; const int bx = blockIdx.x; const int vcu = (G % 8 == 0) ? (bx % 8) * (G / 8) + bx / 8 : bx;
    for (int u = tid; u < (LDS_BYTES - LDSCTL_OFF) / 4; u += NTHR) ((LAS unsigned*)(lds + LDSCTL_OFF))[u] = 0u;
    __syncthreads();
#if MK_SINGLE
    XcdBarrier bar = xcd_barrier_post((unsigned*)(arg_ptr()->ws + WS_CTL) + CW_BAR, (volatile LAS unsigned*)(lds + MISC_OFF) + 8);
#endif
    const int lo = arg_ptr()->ph_lo, hi = arg_ptr()->ph_hi;
    const int repmask = arg_ptr()->rep_mask;
#pragma nounroll
    for (int ph = lo; ph < hi; ++ph) {
        const int layer = (ph - 1) / PH_PER_LAYER, sub = ph == 0 ? 7 : (ph - 1) % PH_PER_LAYER;
#pragma nounroll
        for (int rep = 0; rep <= ((repmask >> sub) & 1); ++rep) {
#if MK_SINGLE
            if (ph > lo || rep > 0) { if (ph == 1 && rep == 0) cg::this_grid().sync(); else xcd_barrier(bar); }
#endif
            if (sub == 7) { if (PHMASK & 128) phase_prologue(arg_ptr(), lds, vcu, G); }
            else if (sub == 0) { if (PHMASK & 1) {
                unsigned char* ws = arg_ptr()->ws;
                pg8::Gemm g{(const pg8::bf16_t*)(ws + WS_HB), (const pg8::bf16_t*)(ws + WS_WIN) + (size_t)layer * INW * DM, M, INW, DM};
                pg8::StaticOrder S; S.init(M, INW, G, bx);
                pg8::EpiProj E{(pg8::bf16_t*)(ws + WS_PROJ), QSCALE};
                pg8::gemm_phase<pg8::EpiProj, pg8::StaticOrder, true, true>(lds, g, S, E); }
            } else if (sub == 1) { if (PHMASK & 2) {
                for (int v = vcu; v < NVCU; v += G) phase_attention(arg_ptr(), layer, lds, v); }
            } else if (sub == 2) { if (PHMASK & 4) {
                ArgP ap = arg_ptr(); unsigned char* ws = ap->ws;
                const float* hres = (layer == 0) ? ap->in[0] : ap->out;
                pg8::Gemm g{(const pg8::bf16_t*)(ws + WS_MIX), (const pg8::bf16_t*)(ws + WS_WO) + (size_t)layer * DM * DM, M, DM, DM};
                pg8::StaticOrder S; S.init(M, DM, G, bx);
                pg8::EpiResid E{hres, (float*)(ws + WS_Z), ALPHA};
                pg8::gemm_phase<pg8::EpiResid, pg8::StaticOrder, true, true>(lds, g, S, E); }
            } else if (sub == 3) { if (PHMASK & 8) {
                ArgP ap = arg_ptr(); unsigned char* ws = ap->ws;
                phase_ln1((const float*)(ws + WS_Z), ap->in[8] + layer * DM, ap->in[9] + layer * DM, (float*)(ws + WS_H1), (bf16*)(ws + WS_H1B), vcu, G); }
            } else if (sub == 4) { if (PHMASK & 16) {
                unsigned char* ws = arg_ptr()->ws;
                pg8::Gemm g{(const pg8::bf16_t*)(ws + WS_H1B), (const pg8::bf16_t*)(ws + WS_WQ) + (size_t)layer * QW * DM, M, QW, DM};
                pg8::StaticOrder S; S.init(M, QW, G, bx);
                pg8::EpiBf16<0> E{(pg8::bf16_t*)(ws + WS_QP), QW, nullptr, 0, 0, 1.f};
                pg8::gemm_phase<pg8::EpiBf16<0>, pg8::StaticOrder, true, true>(lds, g, S, E); }
            } else if (sub == 5) { if (PHMASK & 32) {
                for (int v = vcu; v < NVCU; v += G) phase_score(arg_ptr(), layer, lds, v, G); }
            } else { if (PHMASK & 64) {
                phase_gather(arg_ptr(), layer, vcu, G); }
            }
        }
    }
}

extern "C" void kernel_launch(void* const* d_in, const int* in_sizes, int n_in, void* d_out, int out_size, void* d_ws, size_t ws_size, hipStream_t stream) {
    static int grid = 0;
    if (grid == 0) {
        if (n_in != 16 || in_sizes[0] != M * DM || out_size != M * DM || ws_size < WS_END) { fprintf(stderr, "kernel_launch: unexpected shapes (n_in %d, in0 %d, out %d, ws %zu)\n", n_in, n_in > 0 ? in_sizes[0] : -1, out_size, ws_size); grid = -1; return; }
        int dev = 0, cus = 0, per_cu = 0;
        if (hipGetDevice(&dev) != hipSuccess || hipDeviceGetAttribute(&cus, hipDeviceAttributeMultiprocessorCount, dev) != hipSuccess) { grid = -1; return; }
        if (hipFuncSetAttribute((const void*)fwd_kernel, hipFuncAttributeMaxDynamicSharedMemorySize, LDS_BYTES) != hipSuccess) { fprintf(stderr, "kernel_launch: hipFuncSetAttribute failed\n"); grid = -1; return; }
        if (hipOccupancyMaxActiveBlocksPerMultiprocessor(&per_cu, (const void*)fwd_kernel, NTHR, LDS_BYTES) != hipSuccess || per_cu < 1) { fprintf(stderr, "kernel_launch: occupancy query says %d blocks per CU\n", per_cu); (void)hipGetLastError(); grid = -1; return; }
        grid = cus;
        if (grid > NVCU) grid = NVCU;
    }
    if (grid < 0) return;
    (void)hipMemsetAsync((char*)d_ws + WS_CTL, 0, CTL_ZERO_BYTES, stream);
    Args a{};
    for (int i = 0; i < 16; ++i) a.in[i] = (const float*)d_in[i];
    a.out = (float*)d_out; a.ws = (unsigned char*)d_ws; a.rep_mask = REPMASK; a.pad = 0;
#if MK_SINGLE
    a.ph_lo = 0; a.ph_hi = NPHASE;
    void* params[] = {&a};
    hipError_t e = hipLaunchCooperativeKernel((const void*)fwd_kernel, dim3(grid), dim3(NTHR), params, LDS_BYTES, stream);
    if (e != hipSuccess) fprintf(stderr, "kernel_launch: cooperative launch failed: %s (grid %d)\n", hipGetErrorString(e), grid);
#else
    for (int ph = 0; ph < NPHASE; ++ph) { a.ph_lo = ph; a.ph_hi = ph + 1; hipLaunchKernelGGL(fwd_kernel, dim3(grid), dim3(NTHR), LDS_BYTES, stream, a); }
#endif
}
```
